# Optimizing an MI355X kernel written in HIP

```python
import jax, jax.numpy as jnp
from jax import lax
import numpy as np

D_MODEL = 2048
BATCH = 4
SEQ = 2048
DEPTH = 2
DEC_BATCH = 16
DEC_SEQ = 32
PAST_LEN = 4096

CHUNK = 64
D_MIX = D_MODEL
D_GROUP = D_MIX // 4
H_RET = 4
DK_RET = D_GROUP // H_RET
DV_RET = D_GROUP // H_RET
ROPE_BASE = 10000.0
H_LRU = 8
BLK_LRU = D_GROUP // H_LRU
LRU_C = 8.0
CONV_W = 4
H_SG = 4
SG_CHUNK = 128
H_DN = 4
DK_DN = D_GROUP // H_DN
DV_DN = D_GROUP // H_DN
D_IN = 12 * D_GROUP + 2 * H_DN
D_FF = 5632
ALPHA = (2.0 * DEPTH) ** 0.25
BETA_INIT = (8.0 * DEPTH) ** -0.25
EPS = 1e-5

kernel_name = 'hybrid_streaming_encoder_step'

F32 = jnp.float32


def layer_norm(x, g, b):
    xf = x.astype(F32)
    mu = jnp.mean(xf, -1, keepdims=True)
    var = jnp.mean(jnp.square(xf - mu), -1, keepdims=True)
    return ((xf - mu) * lax.rsqrt(var + EPS) * g + b).astype(x.dtype)


def swiglu(x, w_in, w_out):
    gate, up = jnp.split(x @ w_in, 2, axis=-1)
    return (jax.nn.silu(gate) * up) @ w_out


def causal_conv(x, buf, w):
    L = x.shape[1]
    xp = jnp.concatenate([buf.astype(x.dtype), x], axis=1)
    out = xp[:, 0:L] * w[0]
    for j in range(1, CONV_W):
        out = out + xp[:, j:j + L] * w[j]
    return out, xp[:, -(CONV_W - 1):]


def rotary(x, pos):
    half = x.shape[-1] // 2
    inv = ROPE_BASE ** (-jnp.arange(half, dtype=F32) / half)
    ang = pos.astype(F32)[:, None] * inv[None, :]
    cos = jnp.cos(ang)[None, :, None, :]
    sin = jnp.sin(ang)[None, :, None, :]
    x1, x2 = x[..., :half], x[..., half:]
    return jnp.concatenate([x1 * cos - x2 * sin, x1 * sin + x2 * cos], axis=-1)


def retention(q, k, v, state0):
    B, L, H, dk = q.shape
    c = min(CHUNK, L)
    n = L // c
    log_g = jnp.log1p(-jnp.exp2(-5.0 - jnp.arange(H, dtype=F32)))
    q = q.reshape(B, n, c, H, dk)
    k = k.reshape(B, n, c, H, dk) * (dk ** -0.5)
    v = v.astype(F32).reshape(B, n, c, H, -1)
    idx = jnp.arange(c, dtype=F32)
    diff = idx[:, None] - idx[None, :]
    dmask = jnp.where(diff >= 0, jnp.exp(log_g[:, None, None] * jnp.maximum(diff, 0.0)), 0.0)
    scores = jnp.einsum('bnihd,bnjhd->bnhij', q, k) * dmask
    o_intra = jnp.einsum('bnhij,bnjhe->bnihe', scores, v)
    k_dec = k * jnp.exp(log_g[None, :] * (c - 1.0 - idx)[:, None])[None, None, :, :, None]
    u = jnp.einsum('bnjhd,bnjhe->nbhde', k_dec, v)
    g_c = jnp.exp(log_g * c)[None, :, None, None]

    def step(s, u_n):
        return g_c * s + u_n, s

    s_final, s_starts = lax.scan(step, state0.astype(F32), u)
    q_dec = q * jnp.exp(log_g[None, :] * (idx + 1.0)[:, None])[None, None, :, :, None]
    o_inter = jnp.einsum('bnihd,nbhde->bnihe', q_dec, s_starts)
    o = (o_intra + o_inter).reshape(B, L, H, -1)
    return o, s_final.astype(state0.dtype)


def group_norm(o, g):
    mu = jnp.mean(o, -1, keepdims=True)
    var = jnp.mean(jnp.square(o - mu), -1, keepdims=True)
    on = (o - mu) * lax.rsqrt(var + EPS)
    return on.reshape(o.shape[0], o.shape[1], -1) * g


def rg_lru(x, w_a, b_a, w_x, b_x, lam, h0):
    x = x.astype(F32)
    B, L, _ = x.shape
    xb = x.reshape(B, L, H_LRU, BLK_LRU)
    r = jax.nn.sigmoid(jnp.einsum('blhi,hij->blhj', xb, w_a).reshape(B, L, -1) + b_a)
    i = jax.nn.sigmoid(jnp.einsum('blhi,hij->blhj', xb, w_x).reshape(B, L, -1) + b_x)
    log_a = -LRU_C * r * jax.nn.softplus(-lam.astype(F32))
    a = jnp.exp(log_a)
    b = jnp.sqrt(-jnp.expm1(2.0 * log_a)) * (i * x)

    def combine(e1, e2):
        a1, b1 = e1
        a2, b2 = e2
        return a1 * a2, a2 * b1 + b2

    a_cum, b_cum = lax.associative_scan(combine, (a, b), axis=1)
    h = a_cum * h0.astype(F32)[:, None, :] + b_cum
    return h, h[:, -1].astype(h0.dtype)


def spatial_gate(u, v, ln_g, ln_b, w_s, b_s):
    B, L, _ = v.shape
    vn = layer_norm(v, ln_g, ln_b)
    c = min(SG_CHUNK, L)
    n = L // c
    pos = jnp.arange(c)
    mask = (pos[None, :] // CHUNK) <= (pos[:, None] // CHUNK)
    w = jnp.where(mask[None], w_s[:, :c, :c], 0.0)
    vh = vn.reshape(B, n, c, H_SG, -1)
    s = jnp.einsum('hij,bnjhe->bnihe', w, vh) + b_s[:, :c].T[None, None, :, :, None]
    return u * s.reshape(B, L, -1), vn


def l2norm(x):
    xf = x.astype(F32)
    return xf * lax.rsqrt(jnp.sum(xf * xf, -1, keepdims=True) + 1e-6)


def gated_delta(q, k, v, g, beta, state0):
    B, L, H, dk = q.shape
    c = min(CHUNK, L)
    n = L // c

    def chunks(t):
        return t.astype(F32).reshape(B, n, c, H, -1).transpose(0, 3, 1, 2, 4)

    q = chunks(q) * (dk ** -0.5)
    k = chunks(k)
    v = chunks(v)
    g = g.reshape(B, n, c, H).transpose(0, 3, 1, 2)
    beta = beta.reshape(B, n, c, H).transpose(0, 3, 1, 2)
    gc = jnp.cumsum(g, axis=-1)
    tri = jnp.tril(jnp.ones((c, c), bool))
    strict = jnp.tril(jnp.ones((c, c), bool), -1)
    decay = jnp.exp(jnp.where(tri, gc[..., :, None] - gc[..., None, :], -jnp.inf))
    k_beta = k * beta[..., None]
    v_beta = v * beta[..., None]
    a_mat = jnp.where(strict, jnp.einsum('bhnid,bhnjd->bhnij', k_beta, k) * decay, 0.0)
    t_mat = a_mat + jnp.eye(c, dtype=F32)
    u = lax.linalg.triangular_solve(t_mat, v_beta, left_side=True, lower=True, unit_diagonal=True)
    w = lax.linalg.triangular_solve(t_mat, k_beta * jnp.exp(gc)[..., None], left_side=True, lower=True,
                                    unit_diagonal=True)
    attn = jnp.einsum('bhnid,bhnjd->bhnij', q, k) * decay
    q_dec = q * jnp.exp(gc)[..., None]
    g_last = gc[..., -1]
    k_dec = k * jnp.exp(g_last[..., None] - gc)[..., None]
    xs = (jnp.moveaxis(u, 2, 0), jnp.moveaxis(w, 2, 0), jnp.moveaxis(attn, 2, 0),
          jnp.moveaxis(q_dec, 2, 0), jnp.moveaxis(k_dec, 2, 0), jnp.moveaxis(g_last, 2, 0))

    def step(s, inp):
        u_n, w_n, attn_n, qd_n, kd_n, gl_n = inp
        v_new = u_n - jnp.einsum('bhid,bhde->bhie', w_n, s)
        o_n = jnp.einsum('bhid,bhde->bhie', qd_n, s) + jnp.einsum('bhij,bhje->bhie', attn_n, v_new)
        s = s * jnp.exp(gl_n)[..., None, None] + jnp.einsum('bhid,bhie->bhde', kd_n, v_new)
        return s, o_n

    s_final, o = lax.scan(step, state0.astype(F32), xs)
    o = o.transpose(1, 0, 3, 2, 4).reshape(B, L, H, -1)
    return o, s_final.astype(state0.dtype)


def gated_rms_norm(o, g, z):
    on = o * lax.rsqrt(jnp.mean(o * o, -1, keepdims=True) + EPS) * g
    return on.reshape(o.shape[0], o.shape[1], -1) * jax.nn.silu(z.astype(F32))


def split_columns(proj):
    sizes = (D_GROUP,) * 4 + (D_GROUP,) * 2 + (D_GROUP,) * 2 + (3 * D_GROUP, D_GROUP, H_DN, H_DN)
    idx = np.cumsum(sizes)[:-1].tolist()
    return jnp.split(proj, idx, axis=-1)


def token_mixers(h, pos, s_ret, s_lru, s_lru_conv, s_dn, s_dn_conv, p):
    B, L, _ = h.shape
    proj = h @ p['w_mix_in']
    a_q, a_k, a_v, a_g, b_y, b_x, c_u, c_v, d_qkv, d_z, d_a, d_b = split_columns(proj)
    q = rotary(a_q.astype(F32).reshape(B, L, H_RET, DK_RET), pos)
    k = rotary(a_k.astype(F32).reshape(B, L, H_RET, DK_RET), pos)
    o_ret, s_ret_new = retention(q, k, a_v.reshape(B, L, H_RET, DV_RET), s_ret)
    out_a = group_norm(o_ret, p['ret_norm_g']) * jax.nn.silu(a_g.astype(F32))
    xc, lru_conv_new = causal_conv(b_x, s_lru, p['lru_conv_w']) if False else causal_conv(b_x, s_lru_conv, p['lru_conv_w'])
    hs, lru_h_new = rg_lru(xc + p['lru_conv_b'], p['lru_w_a'], p['lru_b_a'], p['lru_w_x'], p['lru_b_x'],
                           p['lru_lam'], s_lru)
    out_b = hs * jax.nn.gelu(b_y.astype(F32))
    out_c, sg_v = spatial_gate(jax.nn.gelu(c_u), jax.nn.gelu(c_v), p['sg_ln_g'], p['sg_ln_b'],
                               p['sg_w'], p['sg_b'])
    qkv, dn_conv_new = causal_conv(d_qkv, s_dn_conv, p['dn_conv_w'])
    dq, dk, dv = jnp.split(jax.nn.silu(qkv), 3, axis=-1)
    dq = l2norm(dq.reshape(B, L, H_DN, DK_DN))
    dk = l2norm(dk.reshape(B, L, H_DN, DK_DN))
    g = -jnp.exp(p['dn_a_log'].astype(F32)) * jax.nn.softplus(d_a.astype(F32) + p['dn_dt_bias'])
    beta = jax.nn.sigmoid(d_b.astype(F32))
    o_dn, s_dn_new = gated_delta(dq, dk, dv.reshape(B, L, H_DN, DV_DN), g, beta, s_dn)
    out_d = gated_rms_norm(o_dn, p['dn_norm_g'], d_z)
    merged = jnp.concatenate([out_a, out_b, out_c.astype(F32), out_d], axis=-1).astype(h.dtype)
    return merged @ p['w_mix_out'], (s_ret_new, lru_h_new, lru_conv_new, s_dn_new, dn_conv_new, sg_v)


def run_trunk(x, pos, init_states, params):
    new_states = []
    for l in range(DEPTH):
        p = params[l]
        x = layer_norm(ALPHA * x + 0.5 * swiglu(x, p['ffn1_w_in'], p['ffn1_w_out']), p['ln1_g'], p['ln1_b'])
        mix, st = token_mixers(x, pos, *init_states[l], p)
        x = layer_norm(ALPHA * x + mix, p['ln2_g'], p['ln2_b'])
        x = layer_norm(ALPHA * x + 0.5 * swiglu(x, p['ffn2_w_in'], p['ffn2_w_out']), p['ln3_g'], p['ln3_b'])
        new_states.append(st)
    return x, new_states


def setup_inputs(seed: int = 0) -> dict:
    key = jax.random.key(seed)
    ks = iter(jax.random.split(key, 64))

    def nrm(shape, scale):
        return jax.random.normal(next(ks), shape, F32) * scale

    def unif(shape, lo, hi):
        return jax.random.uniform(next(ks), shape, F32, lo, hi)

    G = D_GROUP
    inp = {}
    inp['x_prompt'] = nrm((BATCH, SEQ, D_MODEL), 1.0)
    inp['x_sample'] = nrm((DEC_BATCH, DEC_SEQ, D_MODEL), 1.0)
    inp['state_ret'] = nrm((DEPTH, DEC_BATCH, H_RET, DK_RET, DV_RET), 1.0)
    inp['state_lru_h'] = nrm((DEPTH, DEC_BATCH, G), 0.5)
    inp['state_lru_conv'] = nrm((DEPTH, DEC_BATCH, CONV_W - 1, G), 1.0)
    inp['state_dn'] = nrm((DEPTH, DEC_BATCH, H_DN, DK_DN, DV_DN), 0.1)
    inp['state_dn_conv'] = nrm((DEPTH, DEC_BATCH, CONV_W - 1, 3 * G), 1.0)
    inp['ffn1_w_in'] = nrm((DEPTH, D_MODEL, 2 * D_FF), D_MODEL ** -0.5)
    inp['ffn1_w_out'] = nrm((DEPTH, D_FF, D_MODEL), BETA_INIT * D_FF ** -0.5)
    inp['ln1_g'] = 1.0 + nrm((DEPTH, D_MODEL), 0.02)
    inp['ln1_b'] = nrm((DEPTH, D_MODEL), 0.02)
    inp['w_mix_in'] = nrm((DEPTH, D_MODEL, D_IN), D_MODEL ** -0.5)
    inp['ret_norm_g'] = 1.0 + nrm((DEPTH, G), 0.02)
    inp['lru_conv_w'] = nrm((DEPTH, CONV_W, G), 0.5)
    inp['lru_conv_b'] = nrm((DEPTH, G), 0.02)
    inp['lru_w_a'] = nrm((DEPTH, H_LRU, BLK_LRU, BLK_LRU), BLK_LRU ** -0.5)
    inp['lru_b_a'] = nrm((DEPTH, G), 0.1)
    inp['lru_w_x'] = nrm((DEPTH, H_LRU, BLK_LRU, BLK_LRU), BLK_LRU ** -0.5)
    inp['lru_b_x'] = nrm((DEPTH, G), 0.1)
    a_c = unif((DEPTH, G), 0.9, 0.999)
    a_base = a_c ** (1.0 / LRU_C)
    inp['lru_lam'] = jnp.log(a_base) - jnp.log1p(-a_base)
    inp['sg_ln_g'] = 1.0 + nrm((DEPTH, G), 0.02)
    inp['sg_ln_b'] = nrm((DEPTH, G), 0.02)
    inp['sg_w'] = nrm((DEPTH, H_SG, SG_CHUNK, SG_CHUNK), 0.5 * SG_CHUNK ** -0.5)
    inp['sg_b'] = 1.0 + nrm((DEPTH, H_SG, SG_CHUNK), 0.1)
    inp['dn_conv_w'] = nrm((DEPTH, CONV_W, 3 * G), 0.5)
    inp['dn_a_log'] = jnp.log(unif((DEPTH, H_DN), 1.0, 16.0))
    dt = jnp.exp(unif((DEPTH, H_DN), float(np.log(1e-3)), float(np.log(1e-1))))
    inp['dn_dt_bias'] = dt + jnp.log(-jnp.expm1(-dt))
    inp['dn_norm_g'] = 1.0 + nrm((DEPTH, DV_DN), 0.02)
    inp['w_mix_out'] = nrm((DEPTH, D_MIX, D_MODEL), BETA_INIT * D_MIX ** -0.5)
    inp['ln2_g'] = 1.0 + nrm((DEPTH, D_MODEL), 0.02)
    inp['ln2_b'] = nrm((DEPTH, D_MODEL), 0.02)
    inp['ffn2_w_in'] = nrm((DEPTH, D_MODEL, 2 * D_FF), D_MODEL ** -0.5)
    inp['ffn2_w_out'] = nrm((DEPTH, D_FF, D_MODEL), BETA_INIT * D_FF ** -0.5)
    inp['ln3_g'] = 1.0 + nrm((DEPTH, D_MODEL), 0.02)
    inp['ln3_b'] = nrm((DEPTH, D_MODEL), 0.02)
    return inp


def reference(x_prompt, x_sample, state_ret, state_lru_h, state_lru_conv, state_dn, state_dn_conv,
              ffn1_w_in, ffn1_w_out, ln1_g, ln1_b, w_mix_in, ret_norm_g, lru_conv_w, lru_conv_b,
              lru_w_a, lru_b_a, lru_w_x, lru_b_x, lru_lam, sg_ln_g, sg_ln_b, sg_w, sg_b,
              dn_conv_w, dn_a_log, dn_dt_bias, dn_norm_g, w_mix_out, ln2_g, ln2_b,
              ffn2_w_in, ffn2_w_out, ln3_g, ln3_b):
    params = [dict(ffn1_w_in=ffn1_w_in[l], ffn1_w_out=ffn1_w_out[l], ln1_g=ln1_g[l], ln1_b=ln1_b[l],
                   w_mix_in=w_mix_in[l], ret_norm_g=ret_norm_g[l], lru_conv_w=lru_conv_w[l],
                   lru_conv_b=lru_conv_b[l], lru_w_a=lru_w_a[l], lru_b_a=lru_b_a[l], lru_w_x=lru_w_x[l],
                   lru_b_x=lru_b_x[l], lru_lam=lru_lam[l], sg_ln_g=sg_ln_g[l], sg_ln_b=sg_ln_b[l],
                   sg_w=sg_w[l], sg_b=sg_b[l], dn_conv_w=dn_conv_w[l], dn_a_log=dn_a_log[l],
                   dn_dt_bias=dn_dt_bias[l], dn_norm_g=dn_norm_g[l], w_mix_out=w_mix_out[l],
                   ln2_g=ln2_g[l], ln2_b=ln2_b[l], ffn2_w_in=ffn2_w_in[l], ffn2_w_out=ffn2_w_out[l],
                   ln3_g=ln3_g[l], ln3_b=ln3_b[l])
              for l in range(DEPTH)]

    bp, lp = x_prompt.shape[0], x_prompt.shape[1]
    dt_p = x_prompt.dtype
    prompt_init = [(jnp.zeros((bp, H_RET, DK_RET, DV_RET), dt_p), jnp.zeros((bp, D_GROUP), dt_p),
                    jnp.zeros((bp, CONV_W - 1, D_GROUP), dt_p), jnp.zeros((bp, H_DN, DK_DN, DV_DN), dt_p),
                    jnp.zeros((bp, CONV_W - 1, 3 * D_GROUP), dt_p)) for _ in range(DEPTH)]
    y_prompt, st_p = run_trunk(x_prompt, jnp.arange(lp), prompt_init, params)

    ls = x_sample.shape[1]
    sample_init = [(state_ret[l], state_lru_h[l], state_lru_conv[l], state_dn[l], state_dn_conv[l])
                   for l in range(DEPTH)]
    y_sample, st_s = run_trunk(x_sample, PAST_LEN + jnp.arange(ls), sample_init, params)

    ret_p = jnp.stack([s[0] for s in st_p])
    lru_h_p = jnp.stack([s[1] for s in st_p])
    lru_conv_p = jnp.stack([s[2] for s in st_p])
    dn_p = jnp.stack([s[3] for s in st_p])
    dn_conv_p = jnp.stack([s[4] for s in st_p])
    ret_s = jnp.stack([s[0] for s in st_s])
    lru_h_s = jnp.stack([s[1] for s in st_s])
    lru_conv_s = jnp.stack([s[2] for s in st_s])
    dn_s = jnp.stack([s[3] for s in st_s])
    dn_conv_s = jnp.stack([s[4] for s in st_s])
    sg_v_s = jnp.stack([s[5] for s in st_s])
    return (y_prompt, y_sample, ret_p, lru_h_p, lru_conv_p, dn_p, dn_conv_p,
            ret_s, lru_h_s, lru_conv_s, dn_s, dn_conv_s, sg_v_s)
```

```cpp
#ifndef HOST_EMU
#include <hip/hip_runtime.h>
#endif
#include <cstdio>
#include <cstdint>
#include <cmath>

typedef unsigned short bf16;
typedef short bf16x8 __attribute__((ext_vector_type(8)));
typedef short s16x4 __attribute__((ext_vector_type(4)));
typedef float f32x4 __attribute__((ext_vector_type(4)));
typedef float f32x2 __attribute__((ext_vector_type(2)));
typedef unsigned u32x4 __attribute__((ext_vector_type(4)));
typedef unsigned u32x2 __attribute__((ext_vector_type(2)));
#ifdef HOST_EMU
#define LAS
#define GAS
#define WAIT_VM(n) ((void)0)
#define WAIT_LGKM(n) ((void)0)
#define SHFL_XOR(v, m) emu::shfl_xor_f((v), (m))
#define DS_READ_TR16(p) emu::ds_read_tr16((const void*)(p))
#define LDS_DECL(name) unsigned char* name = emu::cur->wg->lds
#define DEV inline
#define __expf expf
#else
#define LAS __attribute__((address_space(3)))
#define GAS __attribute__((address_space(1)))
#define WAIT_VM(n) asm volatile("s_waitcnt vmcnt(" #n ")" ::: "memory")
#define WAIT_LGKM(n) asm volatile("s_waitcnt lgkmcnt(" #n ")" ::: "memory")
#define SHFL_XOR(v, m) __shfl_xor((v), (m))
#define DS_READ_TR16(p) __builtin_amdgcn_ds_read_tr16_b64_v4i16((LAS s16x4*)(p))
#define LDS_DECL(name) extern __shared__ __attribute__((aligned(16))) unsigned char name[]
#define DEV __device__ __forceinline__
#endif
#define RLX_AGENT __ATOMIC_RELAXED, __HIP_MEMORY_SCOPE_AGENT

DEV unsigned f2bf(float f) { unsigned u = __builtin_bit_cast(unsigned, f); return (u + 0x7fffu + ((u >> 16) & 1u)) >> 16; }
DEV unsigned pk2(float lo, float hi) { return f2bf(lo) | (f2bf(hi) << 16); }
DEV float bf2f(bf16 h) { return __builtin_bit_cast(float, ((unsigned)h) << 16); }
DEV float bflo(unsigned u) { return __builtin_bit_cast(float, u << 16); }
DEV float bfhi(unsigned u) { return __builtin_bit_cast(float, u & 0xffff0000u); }
DEV f32x4 mfma16(bf16x8 a, bf16x8 b, f32x4 c) { return __builtin_amdgcn_mfma_f32_16x16x32_bf16(a, b, c, 0, 0, 0); }
DEV float sigmoidf_(float x) { return 1.f / (1.f + __expf(-x)); }
DEV float siluf_(float x) { return x / (1.f + __expf(-x)); }
DEV float geluf_(float x) { const float u = 0.7978845608028654f * (x + 0.044715f * x * x * x); return x / (1.f + __expf(-2.f * u)); }
DEV float softplusf_(float x) { return fmaxf(x, 0.f) + log1pf(__expf(-fabsf(x))); }

#ifndef CFG_BATCH
#define CFG_BATCH 4
#define CFG_SEQ 2048
#define CFG_DB 16
#define CFG_FF 5632
#endif
constexpr int D = 2048, BATCH = CFG_BATCH, SEQ = CFG_SEQ, DB = CFG_DB, DS = 32, FF = CFG_FF, DEPTH = 2, PAST = 4096;
constexpr int MP = BATCH * SEQ, MS = DB * DS, M = MP + MS;
constexpr int GW = 512;
constexpr int NPROJ = 6144, NPADW = 6400, DIN = 6152;
constexpr int NCH = SEQ / 64, NPCH = BATCH * NCH, NCHUNK = NPCH + DB;
constexpr float ALPHA = 1.4142135623730951f, LN_EPS = 1e-5f;
static_assert(MP % 256 == 0 && MS % 256 == 0 && FF % 128 == 0 && SEQ % 128 == 0, "tile divisibility");

namespace pg8 {
#define PG8_LAS LAS
typedef unsigned short bf16_t;
constexpr int BM = 256, BK = 64, HALF = 128, HTB = HALF * BK * 2  , STAGE_BYTES = 8 * HTB, NXCD = 8, WGM = 8;

__host__ __device__ __forceinline__ int lds_byte(int r, int c) { const int st = (r >> 4) * 2 + (c >> 5), rr = r & 15, cc = c & 31, ob = rr * 64 + cc * 2; return st * 1024 + (ob ^ (((ob >> 9) & 1) << 5)); }
__host__ __device__ __forceinline__ void stage_rc(int b, int& R, int& C) { const int st = b / 1024, sb = b % 1024, swz = sb ^ (((sb >> 9) & 1) << 5); R = (st >> 1) * 16 + swz / 64; C = (st & 1) * 32 + (swz % 64) / 2; }
__host__ __device__ __forceinline__ int perm32(int rho) { const int n = rho >> 4, i = rho & 15; return 8 * (i >> 2) + 4 * n + (i & 3); }

struct Unit { int pm, pn; };
struct Gemm { const bf16_t* A; const bf16_t* Bt; int M, N, K; };

struct StaticOrder {
    int nM, nN, nwg, G, c;
    __host__ __device__ void init(int M, int N, int G_, int c_) { nM = M / BM; nN = N / BM; nwg = nM * nN; G = G_; c = c_; }
    __host__ __device__ bool next(int i, Unit& u) const {
        const long L = (long)i * G + c; if (L >= nwg) return false;
        int wgid = (int)L; { const int q = nwg / NXCD, r = nwg % NXCD, xcd = wgid % NXCD, off = wgid / NXCD; wgid = (xcd < r ? xcd * (q + 1) : r * (q + 1) + (xcd - r) * q) + off; }
        const int nig = WGM * nN, gid = wgid / nig, fm = gid * WGM, gsz = (nM - fm) < WGM ? (nM - fm) : WGM;
        u.pm = fm + ((wgid % nig) % gsz); u.pn = (wgid % nig) / gsz; return true;
    }
    __device__ __forceinline__ void a_ready(const Unit&) const {}
    __device__ __forceinline__ void done(const Unit&) const {}
};

template <class Epi, class Sched, bool ALIGN_EPI = false, bool SP2 = false>
__device__ __forceinline__ void gemm_phase(PG8_LAS unsigned char* lds, const Gemm g, const Sched& S, const Epi& E) {
    const int tid = threadIdx.x, wid = __builtin_amdgcn_readfirstlane(tid >> 6), lane = tid & 63, wr = wid >> 2, wc = wid & 3, fr = lane & 15, fq = lane >> 4;
    const int K = g.K, nt = K / BK;
    unsigned voffA[2], voffB[2];
#pragma unroll
    for (int i = 0; i < 2; ++i) { int R, C; stage_rc(tid * 16 + i * 8192, R, C); const int Rb = Epi::PERM ? ((R & ~31) + perm32(R & 31)) : R;
        voffA[i] = (unsigned)(R * K + C) * 2u; voffB[i] = (unsigned)(Rb * K + C) * 2u; }
    const size_t kstep = (size_t)(BK * 2);
    const size_t hstep = (size_t)HALF * K * 2;
    const size_t tstep = 2 * hstep;
    const unsigned ldsw = (unsigned)wid * 1024u;
    const int aoff = lds_byte(wr * 64 + fr, fq * 8), boff = lds_byte(wc * 32 + fr, fq * 8);
#define PG8_SA(b, h) (((b) * 2 + (h)) * HTB)
#define PG8_SB(b, h) ((4 + (b) * 2 + (h)) * HTB)
#define PG8_STAGE(bufoff, gbase, voff) do { _Pragma("unroll") for (int _i = 0; _i < 2; ++_i) \
        __builtin_amdgcn_global_load_lds((const unsigned*)((const char*)(gbase) + (voff)[_i]), (PG8_LAS unsigned*)(lds + (bufoff) + ldsw + _i * 8192), 16, 0, 0); } while (0)
#define PG8_LDA(dst, b, h) do { _Pragma("unroll") for (int m = 0; m < 4; ++m) _Pragma("unroll") for (int k = 0; k < 2; ++k) dst[m][k] = *(const PG8_LAS bf16x8*)(lds + PG8_SA(b, h) + aoff + m * 2048 + k * 1024); } while (0)
#define PG8_LDB(dst, b, h) do { _Pragma("unroll") for (int n = 0; n < 2; ++n) _Pragma("unroll") for (int k = 0; k < 2; ++k) dst[n][k] = *(const PG8_LAS bf16x8*)(lds + PG8_SB(b, h) + boff + n * 2048 + k * 1024); } while (0)
#define PG8_MMA(ai, bj, At, Bt) do { __builtin_amdgcn_s_setprio(1); _Pragma("unroll") for (int m = 0; m < 4; ++m) _Pragma("unroll") for (int n = 0; n < 2; ++n) _Pragma("unroll") for (int k = 0; k < 2; ++k) \
        acc[ai][bj][m][n] = __builtin_amdgcn_mfma_f32_16x16x32_bf16(Bt[n][k], At[m][k], acc[ai][bj][m][n], 0, 0, 0); __builtin_amdgcn_s_setprio(0); } while (0)
#define PG8_WAIT_V(n) WAIT_VM(n)
#define PG8_WAIT_L(n) WAIT_LGKM(n)
#define PG8_BAR __builtin_amdgcn_s_barrier()
#define PG8_SCHED __builtin_amdgcn_sched_barrier(0)
    Unit cur, nxt; int ui = 0;
    if (!S.next(0, cur)) return;
    f32x4 acc[2][2][4][2];
#pragma unroll
    for (int a = 0; a < 2; ++a)
#pragma unroll
        for (int b = 0; b < 2; ++b)
#pragma unroll
            for (int m = 0; m < 4; ++m)
#pragma unroll
                for (int n = 0; n < 2; ++n) acc[a][b][m][n] = (f32x4){0.f, 0.f, 0.f, 0.f};
    bf16x8 At[4][2], B0[2][2], B1[2][2];
    const char* cA = (const char*)g.A + (size_t)cur.pm * tstep; const char* cB = (const char*)g.Bt + (size_t)cur.pn * tstep;
    S.a_ready(cur);
    if constexpr (SP2) {
        PG8_STAGE(PG8_SB(0, 0), cB, voffB); PG8_STAGE(PG8_SB(0, 1), cB + hstep, voffB); PG8_STAGE(PG8_SA(0, 0), cA, voffA); PG8_STAGE(PG8_SA(0, 1), cA + hstep, voffA);
        if (wr == 1) PG8_BAR;
        PG8_WAIT_V(2); PG8_BAR;
        PG8_STAGE(PG8_SB(1, 0), cB + kstep, voffB); PG8_STAGE(PG8_SA(1, 0), cA + kstep, voffA); PG8_STAGE(PG8_SB(1, 1), cB + hstep + kstep, voffB);
        PG8_WAIT_V(6); PG8_BAR;
    } else {
        PG8_STAGE(PG8_SB(0, 0), cB, voffB); PG8_STAGE(PG8_SA(0, 0), cA, voffA); PG8_STAGE(PG8_SB(0, 1), cB + hstep, voffB); PG8_STAGE(PG8_SA(0, 1), cA + hstep, voffA);
        if (wr == 1) PG8_BAR;
        PG8_WAIT_V(4); PG8_BAR;
        PG8_STAGE(PG8_SB(1, 0), cB + kstep, voffB); PG8_STAGE(PG8_SA(1, 0), cA + kstep, voffA); PG8_STAGE(PG8_SB(1, 1), cB + hstep + kstep, voffB);
        PG8_WAIT_V(6); PG8_BAR;
    }
    for (;;) {
        const bool has_next = S.next(ui + 1, nxt);
        const char* nA = has_next ? (const char*)g.A + (size_t)nxt.pm * tstep : cA; const char* nB = has_next ? (const char*)g.Bt + (size_t)nxt.pn * tstep : cB;
        for (int t = 0; t < nt; t += 2) {
            const bool last = (t == nt - 2);
            const char* a1 = cA + (size_t)(t + 1) * kstep;
            const char* a2 = last ? nA : cA + (size_t)(t + 2) * kstep; const char* b2 = last ? nB : cB + (size_t)(t + 2) * kstep;
            const char* a3 = a2 + kstep; const char* b3 = b2 + kstep;
            if (last && has_next) S.a_ready(nxt);
            if constexpr (SP2) {
            PG8_LDB(B0, 0, 0); PG8_LDB(B1, 0, 1); PG8_SCHED; PG8_LDA(At, 0, 0); PG8_STAGE(PG8_SA(1, 1), a1 + hstep, voffA);
            PG8_WAIT_V(8); PG8_WAIT_L(0); PG8_BAR; PG8_MMA(0, 0, At, B0); PG8_MMA(0, 1, At, B1); PG8_BAR; PG8_SCHED;
            PG8_LDA(At, 0, 1); PG8_STAGE(PG8_SB(0, 0), b2, voffB); PG8_STAGE(PG8_SB(0, 1), b2 + hstep, voffB); PG8_STAGE(PG8_SA(0, 0), a2, voffA);
            PG8_WAIT_V(8); PG8_WAIT_L(0); PG8_BAR; PG8_MMA(1, 0, At, B0); PG8_MMA(1, 1, At, B1); PG8_BAR; PG8_SCHED;
            PG8_LDB(B0, 1, 0); PG8_LDB(B1, 1, 1); PG8_SCHED; PG8_LDA(At, 1, 0); PG8_STAGE(PG8_SA(0, 1), a2 + hstep, voffA);
            PG8_WAIT_V(8); PG8_WAIT_L(0); PG8_BAR; PG8_MMA(0, 0, At, B0); PG8_MMA(0, 1, At, B1); PG8_BAR; PG8_SCHED;
            PG8_LDA(At, 1, 1); PG8_STAGE(PG8_SB(1, 0), b3, voffB); PG8_STAGE(PG8_SB(1, 1), b3 + hstep, voffB); PG8_STAGE(PG8_SA(1, 0), a3, voffA);
            PG8_WAIT_V(8); PG8_WAIT_L(0); PG8_BAR; PG8_MMA(1, 0, At, B0); PG8_MMA(1, 1, At, B1); PG8_BAR; PG8_SCHED;
            } else {
            PG8_LDB(B0, 0, 0); PG8_SCHED; PG8_LDA(At, 0, 0); PG8_STAGE(PG8_SA(1, 1), a1 + hstep, voffA);
            PG8_WAIT_L(8); PG8_BAR; PG8_WAIT_L(0); PG8_MMA(0, 0, At, B0); PG8_BAR; PG8_SCHED;
            PG8_LDB(B1, 0, 1); PG8_STAGE(PG8_SB(0, 0), b2, voffB);
            PG8_BAR; PG8_WAIT_L(0); PG8_MMA(0, 1, At, B1); PG8_BAR;
            PG8_LDA(At, 0, 1); PG8_STAGE(PG8_SA(0, 0), a2, voffA);
            PG8_BAR; PG8_WAIT_L(0); PG8_MMA(1, 0, At, B0); PG8_BAR; PG8_SCHED;
            PG8_STAGE(PG8_SB(0, 1), b2 + hstep, voffB);
            PG8_WAIT_V(6); PG8_BAR; PG8_MMA(1, 1, At, B1); PG8_BAR;
            PG8_LDB(B0, 1, 0); PG8_SCHED; PG8_LDA(At, 1, 0); PG8_STAGE(PG8_SA(0, 1), a2 + hstep, voffA);
            PG8_WAIT_L(8); PG8_BAR; PG8_WAIT_L(0); PG8_MMA(0, 0, At, B0); PG8_BAR; PG8_SCHED;
            PG8_LDB(B1, 1, 1); PG8_STAGE(PG8_SB(1, 0), b3, voffB);
            PG8_BAR; PG8_WAIT_L(0); PG8_MMA(0, 1, At, B1); PG8_BAR;
            PG8_LDA(At, 1, 1); PG8_STAGE(PG8_SA(1, 0), a3, voffA);
            PG8_BAR; PG8_WAIT_L(0); PG8_MMA(1, 0, At, B0); PG8_BAR; PG8_SCHED;
            PG8_STAGE(PG8_SB(1, 1), b3 + hstep, voffB);
            PG8_WAIT_V(6); PG8_BAR; PG8_MMA(1, 1, At, B1); PG8_BAR;
            }
        }
        if constexpr (ALIGN_EPI) { if (wr == 0) PG8_BAR; }
        if constexpr (!Epi::AFTER_DRAIN) { E(acc, cur, wr, wc, fr, fq); S.done(cur); }
        if (!has_next) break;
#pragma unroll
        for (int a = 0; a < 2; ++a)
#pragma unroll
            for (int b = 0; b < 2; ++b)
#pragma unroll
                for (int m = 0; m < 4; ++m)
#pragma unroll
                    for (int n = 0; n < 2; ++n) acc[a][b][m][n] = (f32x4){0.f, 0.f, 0.f, 0.f};
        cur = nxt; cA = nA; cB = nB; ++ui;
        if constexpr (ALIGN_EPI) { if (wr == 1) PG8_BAR; }
    }
    PG8_WAIT_V(0);
    if constexpr (!ALIGN_EPI) { if (wr == 0) PG8_BAR; }
    PG8_BAR;
    if constexpr (Epi::AFTER_DRAIN) { E.fused(acc, cur, wr, wc, fr, fq, lds, wid, lane); S.done(cur); }
#undef PG8_SA
#undef PG8_SB
#undef PG8_STAGE
#undef PG8_LDA
#undef PG8_LDB
#undef PG8_MMA
#undef PG8_WAIT_V
#undef PG8_WAIT_L
#undef PG8_BAR
#undef PG8_SCHED
}
}

constexpr size_t al256(size_t x) { return (x + 255) & ~(size_t)255; }
constexpr size_t cmax(size_t a, size_t b) { return a > b ? a : b; }
constexpr size_t WS_CTL = 0, CTL_ZERO_BYTES = 1u << 20;
constexpr size_t WS_ROT = CTL_ZERO_BYTES;
constexpr size_t WS_LRUW = WS_ROT + al256((size_t)(SEQ + 32) * 64 * 2 * 4);
constexpr size_t WS_SGW = WS_LRUW + al256((size_t)DEPTH * 2 * 8 * 4096 * 2);
constexpr size_t WS_W1I = WS_SGW + al256((size_t)DEPTH * 4 * 16384 * 2);
constexpr size_t WS_W1O = WS_W1I + al256((size_t)2 * FF * D * 2);
constexpr size_t WS_WMI = WS_W1O + al256((size_t)D * FF * 2);
constexpr size_t WS_WMO = WS_WMI + al256((size_t)NPADW * D * 2);
constexpr size_t WS_W2I = WS_WMO + al256((size_t)D * D * 2);
constexpr size_t WS_W2O = WS_W2I + al256((size_t)2 * FF * D * 2);
constexpr size_t WS_XB = WS_W2O + al256((size_t)D * FF * 2);
constexpr size_t WS_XC = WS_XB + al256((size_t)M * D * 2);
constexpr size_t WS_Z = WS_XC + al256((size_t)M * D * 4);
constexpr size_t WS_HP = WS_Z + al256((size_t)M * D * 4);
constexpr size_t WS_GAB = WS_HP + al256(cmax((size_t)M * FF * 2, (size_t)M * NPROJ * 2));
constexpr size_t WS_MRG = WS_GAB + al256((size_t)M * 8 * 4);
constexpr size_t WS_U = WS_MRG + al256((size_t)M * D * 2);
constexpr size_t WS_DNU = WS_U + al256((size_t)NCHUNK * 4 * 16384 * 4);
constexpr size_t WS_DNW = WS_DNU + al256((size_t)M * 512 * 2);
constexpr size_t WS_DNQ = WS_DNW + al256((size_t)M * 512 * 2);
constexpr size_t WS_DNK = WS_DNQ + al256((size_t)M * 512 * 2);
constexpr size_t WS_DNA = WS_DNK + al256((size_t)NCHUNK * 4 * 128 * 64 * 2);
constexpr size_t WS_DNGL = WS_DNA + al256((size_t)NCHUNK * 4 * 64 * 64 * 2);
constexpr size_t WS_DNO = WS_DNGL + al256((size_t)NCHUNK * 4 * 4);
constexpr size_t WS_LRA = WS_DNO + al256((size_t)M * 512 * 4);
constexpr size_t WS_LRH = WS_LRA + al256((size_t)M * 512 * 4);
constexpr size_t WS_LRC = WS_LRH + al256((size_t)M * 512 * 4);
constexpr size_t WS_VN = WS_LRC + al256((size_t)NPCH * 512 * 4);
constexpr size_t WS_END = WS_VN + al256((size_t)M * 512 * 2);
constexpr size_t O_YP = 0, O_YS = O_YP + (size_t)MP * D, O_RETP = O_YS + (size_t)MS * D, O_LHP = O_RETP + (size_t)DEPTH * BATCH * 4 * 16384,
    O_LCP = O_LHP + (size_t)DEPTH * BATCH * 512, O_DNP = O_LCP + (size_t)DEPTH * BATCH * 3 * 512, O_DCP = O_DNP + (size_t)DEPTH * BATCH * 4 * 16384,
    O_RETS = O_DCP + (size_t)DEPTH * BATCH * 3 * 1536, O_LHS = O_RETS + (size_t)DEPTH * DB * 4 * 16384, O_LCS = O_LHS + (size_t)DEPTH * DB * 512,
    O_DNS = O_LCS + (size_t)DEPTH * DB * 3 * 512, O_DCS = O_DNS + (size_t)DEPTH * DB * 4 * 16384, O_SGV = O_DCS + (size_t)DEPTH * DB * 3 * 1536,
    O_END = O_SGV + (size_t)DEPTH * DB * 32 * 512;
constexpr int CW_BAR = 4096;
constexpr int RING_BYTES = 131072, MISC_OFF = RING_BYTES + 320, LDS_BYTES = 147456;
constexpr int NWAVES = 8, NTHREADS = 512;
enum { I_XP = 0, I_XS, I_SRET, I_SLH, I_SLC, I_SDN, I_SDC, I_W1I, I_W1O, I_LN1G, I_LN1B, I_WMI, I_RETG, I_LCW, I_LCB, I_LWA, I_LBA, I_LWX, I_LBX, I_LAM,
       I_SGG, I_SGB, I_SGW, I_SGBS, I_DCW, I_DALOG, I_DDT, I_DNG, I_WMO, I_LN2G, I_LN2B, I_W2I, I_W2O, I_LN3G, I_LN3B, N_IN };
#ifdef HOST_EMU
static const float* const* g_emu_in = nullptr;
#define INP(k) (g_emu_in[k])
#else
DEV const float* in_ptr_(int k) {
    const __attribute__((address_space(4))) char* ka = (const __attribute__((address_space(4))) char*)__builtin_amdgcn_kernarg_segment_ptr();
    const unsigned long long v = *(volatile const __attribute__((address_space(4))) unsigned long long*)(ka + 8 * k);
    return (const float*)(const GAS float*)v;
}
#define INP(k) in_ptr_(k)
#endif

#define XB_TMO      128
#define XB_XCNT(j)  (256  + 64 * (j))
#define XB_XSUB(j)  (1280 + 64 * (j))
#define XB_XGEN(j)  (2304 + 64 * (j))
#define XB_TOP      3328
#define XB_TOPGEN   3392
#define XCD_BAR_WORDS 3456
#define XB_SPIN_CAP (1u << 18)
DEV unsigned xb_ld(unsigned* p)              { return __hip_atomic_load(p, __ATOMIC_RELAXED, __HIP_MEMORY_SCOPE_AGENT); }
DEV unsigned xb_add(unsigned* p, unsigned v) { return __hip_atomic_fetch_add(p, v, __ATOMIC_RELAXED, __HIP_MEMORY_SCOPE_AGENT); }
DEV unsigned xb_xcc_id() { return (unsigned)__builtin_amdgcn_s_getreg((3 << 11) | 20) & 0xFu; }
#define XB_SPIN(cond, bar) do { unsigned _sp = 0; while (cond) { __builtin_amdgcn_s_sleep(1); \
    if ((++_sp & 255u) == 0u) { if (xb_ld(&(bar)[XB_TMO])) break; if (_sp > XB_SPIN_CAP) { atomicAdd(&(bar)[XB_TMO], 1u); break; } } } } while (0)
struct XcdBarrier { unsigned* bar; unsigned x; volatile LAS unsigned* st; };
DEV XcdBarrier xcd_barrier_post(unsigned* bar, volatile LAS unsigned* st) {
    XcdBarrier b; b.bar = bar; b.x = xb_xcc_id(); b.st = st;
    if (threadIdx.x == 0) (void)xb_add(&bar[XB_XCNT(b.x)], 1u);
    return b;
}
DEV void xcd_barrier_complete(unsigned* bar, unsigned x, unsigned& nloc, unsigned& nx) {
    const unsigned G = gridDim.x * gridDim.y * gridDim.z;
    unsigned sum, cnt, mine, sp = 0u;
    for (;;) {
        sum = 0u; cnt = 0u; mine = 0u;
#pragma unroll
        for (unsigned j = 0; j < 16; ++j) { const unsigned c = xb_ld(&bar[XB_XCNT(j)]); sum += c; cnt += (c > 0u) ? 1u : 0u; mine = (j == x) ? c : mine; }
        if (sum == G) break;
        __builtin_amdgcn_s_sleep(1);
        if ((++sp & 255u) == 0u) { if (xb_ld(&bar[XB_TMO])) break; if (sp > XB_SPIN_CAP) { atomicAdd(&bar[XB_TMO], 1u); break; } }
    }
    nloc = mine > 0u ? mine : 1u; nx = cnt > 0u ? cnt : 1u;
}
DEV void xcd_barrier(const XcdBarrier& b) {
    WAIT_VM(0);
    __syncthreads();
    if (threadIdx.x == 0) {
        unsigned* bar = b.bar;
        __builtin_amdgcn_s_waitcnt(0);
        unsigned nloc = b.st[0], nx = b.st[1];
        if (nloc == 0u) { xcd_barrier_complete(bar, b.x, nloc, nx); b.st[0] = nloc; b.st[1] = nx; }
        const unsigned old = xb_add(&bar[XB_XSUB(b.x)], 1u);
        const unsigned gen = old / nloc;
        if (old + 1u == (gen + 1u) * nloc) {
            __builtin_amdgcn_fence(__ATOMIC_RELEASE, "agent");
            WAIT_VM(0);
            const unsigned og = xb_add(&bar[XB_TOP], 1u);
            const unsigned tg = og / nx;
            if (og + 1u == (tg + 1u) * nx) xb_add(&bar[XB_TOPGEN], 1u);
            else XB_SPIN(xb_ld(&bar[XB_TOPGEN]) == tg, bar);
            __builtin_amdgcn_fence(__ATOMIC_ACQUIRE, "agent");
            xb_add(&bar[XB_XGEN(b.x)], 1u);
            WAIT_VM(0);
        } else {
            XB_SPIN(xb_ld(&bar[XB_XGEN(b.x)]) == gen, bar);
            __builtin_amdgcn_fence(__ATOMIC_ACQUIRE, "agent");
            WAIT_VM(0);
        }
    }
    __syncthreads();
}

#ifdef HOST_EMU
#define WAVE_LDS_SYNC() emu::wave_sync()
#else
#define WAVE_LDS_SYNC() do { WAIT_LGKM(0); asm volatile("" ::: "memory"); } while (0)
#endif
DEV float wave_sum(float v) {
#pragma unroll
    for (int o = 1; o < 64; o <<= 1) v += SHFL_XOR(v, o);
    return v;
}
DEV bf16x8 lds_rowfrag(const LAS unsigned char* T, int ldb, int r0, int k0, int lane) { return *(const LAS bf16x8*)(T + (r0 + (lane & 15)) * ldb + (k0 + 8 * (lane >> 4)) * 2); }
DEV bf16x8 lds_trfrag(const LAS unsigned char* T, int ldb, int k0, int c0, int lane) {
    const int g = lane >> 4, q = (lane & 15) >> 2, p = lane & 3;
    const LAS unsigned char* a0 = T + (k0 + 8 * g + q) * ldb + (c0 + 4 * p) * 2;
    const s16x4 lo = DS_READ_TR16(a0), hi = DS_READ_TR16(a0 + 4 * ldb);
    return (bf16x8){lo[0], lo[1], lo[2], lo[3], hi[0], hi[1], hi[2], hi[3]};
}
DEV bf16x8 glb_rowfrag(const bf16* T, size_t ld, int r0, int k0, int lane) { return *(const bf16x8*)(T + (size_t)(r0 + (lane & 15)) * ld + k0 + 8 * (lane >> 4)); }
DEV void unpack8(const u32x4 v, float* f) { f[0] = bflo(v.x); f[1] = bfhi(v.x); f[2] = bflo(v.y); f[3] = bfhi(v.y); f[4] = bflo(v.z); f[5] = bfhi(v.z); f[6] = bflo(v.w); f[7] = bfhi(v.w); }
DEV u32x4 pack8(const float* f) { u32x4 o; o.x = pk2(f[0], f[1]); o.y = pk2(f[2], f[3]); o.z = pk2(f[4], f[5]); o.w = pk2(f[6], f[7]); return o; }

struct Ctx {
    LAS unsigned char* lds; int tid, lane, wave, wg, G, gw, NGW;
    float* out; unsigned char* ws;
};
struct Chunk { int row0, C, rot0, stream, n; bool sample; };
DEV Chunk chunk_of(int ck) {
    Chunk c;
    if (ck < NPCH) { c.sample = false; c.stream = ck / NCH; c.n = ck % NCH; c.row0 = ck * 64; c.C = 64; c.rot0 = c.n * 64; }
    else { c.sample = true; c.stream = ck - NPCH; c.n = 0; c.row0 = MP + 32 * c.stream; c.C = 32; c.rot0 = SEQ; }
    return c;
}

DEV void conv_item(const float* W, int ldw, int k0, int n0, int nvalid, bf16* WT, int K, int drow0, LAS float* scr, int lane) {
#pragma unroll 8
    for (int i = 0; i < 32; ++i) { const int kk = 2 * i + (lane >> 5), c = lane & 31; scr[kk * 33 + c] = (c < nvalid) ? W[(size_t)(k0 + kk) * ldw + n0 + c] : 0.f; }
    WAVE_LDS_SYNC();
    const int c = lane & 7;
#pragma unroll
    for (int j = 0; j < 4; ++j) { const int n = (lane >> 3) + 8 * j; const LAS float* s = scr + (8 * c) * 33 + n;
        u32x4 o; o.x = pk2(s[0 * 33], s[1 * 33]); o.y = pk2(s[2 * 33], s[3 * 33]); o.z = pk2(s[4 * 33], s[5 * 33]); o.w = pk2(s[6 * 33], s[7 * 33]);
        *(u32x4*)(WT + (size_t)(drow0 + n) * K + k0 + 8 * c) = o; }
    WAVE_LDS_SYNC();
}
DEV void convert_layer_weights(const Ctx& X, int l) {
    LAS float* scr = (LAS float*)(X.lds + X.wave * 16384);
    bf16* W1I = (bf16*)(X.ws + WS_W1I); bf16* W1O = (bf16*)(X.ws + WS_W1O); bf16* WMI = (bf16*)(X.ws + WS_WMI); bf16* WMO = (bf16*)(X.ws + WS_WMO);
    bf16* W2I = (bf16*)(X.ws + WS_W2I); bf16* W2O = (bf16*)(X.ws + WS_W2O);
    constexpr int N_IN2 = (D / 64) * (2 * FF / 32), N_OUT = (FF / 64) * (D / 32), N_MI = (D / 64) * 193, N_MO = (D / 64) * (D / 32);
    constexpr int NITEMS = 2 * N_IN2 + 2 * N_OUT + N_MI + N_MO;
    for (int it = X.gw; it < NITEMS; it += X.NGW) {
        int r = it;
        if (r < 2 * N_IN2) { const bool second = r >= N_IN2; if (second) r -= N_IN2; const float* W = (second ? INP(I_W2I) : INP(I_W1I)) + (size_t)l * D * 2 * FF;
            const int nblk = 2 * FF / 32, kb = r / nblk, nb = r % nblk, n0 = nb * 32; const int up = n0 >= FF, nn = up ? n0 - FF : n0;
            conv_item(W, 2 * FF, kb * 64, n0, 32, second ? W2I : W1I, D, 256 * (nn / 128) + 128 * up + (nn % 128), scr, X.lane); continue; }
        r -= 2 * N_IN2;
        if (r < 2 * N_OUT) { const bool second = r >= N_OUT; if (second) r -= N_OUT; const float* W = (second ? INP(I_W2O) : INP(I_W1O)) + (size_t)l * FF * D;
            const int nblk = D / 32, kb = r / nblk, nb = r % nblk; conv_item(W, D, kb * 64, nb * 32, 32, second ? W2O : W1O, FF, nb * 32, scr, X.lane); continue; }
        r -= 2 * N_OUT;
        if (r < N_MI) { const float* W = INP(I_WMI) + (size_t)l * D * DIN; const int kb = r / 193, nb = r % 193;
            conv_item(W, DIN, kb * 64, nb * 32, nb == 192 ? 8 : 32, WMI, D, nb * 32, scr, X.lane); continue; }
        r -= N_MI;
        { const float* W = INP(I_WMO) + (size_t)l * D * D; const int nblk = D / 32, kb = r / nblk, nb = r % nblk; conv_item(W, D, kb * 64, nb * 32, 32, WMO, D, nb * 32, scr, X.lane); }
    }
    { u32x4* z = (u32x4*)(WMI + (size_t)6176 * D); const size_t n16 = (size_t)(NPADW - 6176) * D * 2 / 16;
      for (size_t i = (size_t)X.wg * NTHREADS + X.tid; i < n16; i += (size_t)X.G * NTHREADS) z[i] = (u32x4){0u, 0u, 0u, 0u}; }
}
DEV void prologue_misc(const Ctx& X) {
    const size_t gt = (size_t)X.wg * NTHREADS + X.tid, GT = (size_t)X.G * NTHREADS;
    { float* rot = (float*)(X.ws + WS_ROT);
      for (size_t i = gt; i < (size_t)(SEQ + 32) * 64; i += GT) { const int p = (int)(i / 64), k = (int)(i % 64); const float pos = (float)(p < SEQ ? p : PAST + (p - SEQ));
          const float inv = powf(10000.f, -(float)k / 64.f); const float ang = pos * inv; rot[2 * i] = cosf(ang); rot[2 * i + 1] = sinf(ang); } }
    { bf16* dst = (bf16*)(X.ws + WS_LRUW);
      for (size_t i = gt; i < (size_t)DEPTH * 2 * 8 * 4096; i += GT) { const int ii = (int)(i % 64), j = (int)((i / 64) % 64), h = (int)((i / 4096) % 8), m = (int)((i / 32768) % 2), l = (int)(i / 65536);
          dst[i] = (bf16)f2bf((m ? INP(I_LWX) : INP(I_LWA))[(((size_t)l * 8 + h) * 64 + ii) * 64 + j]); } }
    { bf16* dst = (bf16*)(X.ws + WS_SGW);
      for (size_t i = gt; i < (size_t)DEPTH * 4 * 16384; i += GT) { const int j = (int)(i % 128), ii = (int)((i / 128) % 128); dst[i] = ((j >> 6) <= (ii >> 6)) ? (bf16)f2bf(INP(I_SGW)[i]) : (bf16)0; } }
    { bf16* xb = (bf16*)(X.ws + WS_XB);
      for (int row = X.gw; row < M; row += X.NGW) { const float* src = row < MP ? INP(I_XP) + (size_t)row * D : INP(I_XS) + (size_t)(row - MP) * D;
#pragma unroll
          for (int j = 0; j < 8; ++j) { const f32x4 v = *(const f32x4*)(src + 4 * (X.lane + 64 * j)); u32x2 o; o.x = pk2(v.x, v.y); o.y = pk2(v.z, v.w); *(u32x2*)(xb + (size_t)row * D + 4 * (X.lane + 64 * j)) = o; } } }
}

DEV void ln_phase(const Ctx& X, const float* g, const float* b, float* xf, bool write_xb) {
    const float* Z = (const float*)(X.ws + WS_Z); bf16* xb = (bf16*)(X.ws + WS_XB);
    for (int row = X.gw; row < M; row += X.NGW) {
        const f32x4* zr = (const f32x4*)(Z + (size_t)row * D) + X.lane;
        f32x4 v[8]; float s = 0.f;
#pragma unroll
        for (int j = 0; j < 8; ++j) { v[j] = zr[64 * j]; s += (v[j].x + v[j].y) + (v[j].z + v[j].w); }
        const float mean = wave_sum(s) * (1.f / D); float s2 = 0.f;
#pragma unroll
        for (int j = 0; j < 8; ++j) { v[j] = v[j] - mean; s2 += (v[j].x * v[j].x + v[j].y * v[j].y) + (v[j].z * v[j].z + v[j].w * v[j].w); }
        const float rstd = 1.f / sqrtf(wave_sum(s2) * (1.f / D) + LN_EPS);
#pragma unroll
        for (int j = 0; j < 8; ++j) { const int c = 4 * (X.lane + 64 * j); const f32x4 gg = *(const f32x4*)(g + c), bb = *(const f32x4*)(b + c);
            const f32x4 o = v[j] * rstd * gg + bb; *(f32x4*)(xf + (size_t)row * D + c) = o;
            if (write_xb) { u32x2 p; p.x = pk2(o.x, o.y); p.y = pk2(o.z, o.w); *(u32x2*)(xb + (size_t)row * D + c) = p; } }
    }
}

struct EpiSwiglu {
    static constexpr bool PERM = true, AFTER_DRAIN = false; bf16* H;
    DEV void operator()(const f32x4 (&acc)[2][2][4][2], const pg8::Unit& u, int wr, int wc, int fr, int fq) const {
#pragma unroll
        for (int ai = 0; ai < 2; ++ai)
#pragma unroll
            for (int m = 0; m < 4; ++m) { const int row = u.pm * 256 + ai * 128 + wr * 64 + m * 16 + fr; float o[8];
#pragma unroll
                for (int n = 0; n < 2; ++n)
#pragma unroll
                    for (int j = 0; j < 4; ++j) { const float gt = acc[ai][0][m][n][j], up = acc[ai][1][m][n][j]; o[4 * n + j] = siluf_(gt) * up; }
                *(u32x4*)(H + (size_t)row * FF + u.pn * 128 + wc * 32 + fq * 8) = pack8(o); }
    }
};
struct EpiResid {
    static constexpr bool PERM = true, AFTER_DRAIN = false; const float* xp; const float* xs; float* Z; float scale;
    DEV void operator()(const f32x4 (&acc)[2][2][4][2], const pg8::Unit& u, int wr, int wc, int fr, int fq) const {
#pragma unroll
        for (int ai = 0; ai < 2; ++ai)
#pragma unroll
            for (int m = 0; m < 4; ++m) { const int row = u.pm * 256 + ai * 128 + wr * 64 + m * 16 + fr;
                const float* xr = row < MP ? xp + (size_t)row * D : xs + (size_t)(row - MP) * D;
#pragma unroll
                for (int bj = 0; bj < 2; ++bj) { const int col = u.pn * 256 + bj * 128 + wc * 32 + fq * 8;
#pragma unroll
                    for (int n = 0; n < 2; ++n) { const f32x4 xv = *(const f32x4*)(xr + col + 4 * n); *(f32x4*)(Z + (size_t)row * D + col + 4 * n) = xv * ALPHA + acc[ai][bj][m][n] * scale; } } }
    }
};
struct EpiProj {
    static constexpr bool PERM = true, AFTER_DRAIN = false; bf16* P; float* gab;
    DEV void operator()(const f32x4 (&acc)[2][2][4][2], const pg8::Unit& u, int wr, int wc, int fr, int fq) const {
#pragma unroll
        for (int ai = 0; ai < 2; ++ai)
#pragma unroll
            for (int m = 0; m < 4; ++m) { const int row = u.pm * 256 + ai * 128 + wr * 64 + m * 16 + fr;
                if (u.pn < NPROJ / 256) {
#pragma unroll
                    for (int bj = 0; bj < 2; ++bj) { float o[8];
#pragma unroll
                        for (int n = 0; n < 2; ++n)
#pragma unroll
                            for (int j = 0; j < 4; ++j) o[4 * n + j] = acc[ai][bj][m][n][j];
                        *(u32x4*)(P + (size_t)row * NPROJ + u.pn * 256 + bj * 128 + wc * 32 + fq * 8) = pack8(o); }
                } else if (wc == 0 && fq == 0) { *(f32x4*)(gab + (size_t)row * 8) = acc[ai][0][m][0]; *(f32x4*)(gab + (size_t)row * 8 + 4) = acc[ai][0][m][1]; } }
    }
};

constexpr int LD136 = 272, LD72 = 144;
DEV float ret_log_g(int h) { return log1pf(-exp2f(-5.f - (float)h)); }
DEV void rot_piece(const bf16* src_row_head, const float* rotrow, int d, float scale, LAS unsigned char* T, int j) {
    float x1[8], x2[8], o1[8], o2[8]; unpack8(*(const u32x4*)(src_row_head + d), x1); unpack8(*(const u32x4*)(src_row_head + 64 + d), x2);
#pragma unroll
    for (int i = 0; i < 8; ++i) { const f32x2 cs = *(const f32x2*)(rotrow + 2 * (d + i)); o1[i] = (x1[i] * cs.x - x2[i] * cs.y) * scale; o2[i] = (x1[i] * cs.y + x2[i] * cs.x) * scale; }
    *(LAS u32x4*)(T + j * LD136 + d * 2) = pack8(o1); *(LAS u32x4*)(T + j * LD136 + (64 + d) * 2) = pack8(o2);
}
DEV void ret_u_unit(const Ctx& X, int ck, int h) {
    const Chunk c = chunk_of(ck); const bf16* P = (const bf16*)(X.ws + WS_HP); const float* rot = (const float*)(X.ws + WS_ROT);
    LAS unsigned char* Kd = X.lds; LAS unsigned char* Vs = X.lds + 17408; const float lg = ret_log_g(h);
    for (int idx = X.tid; idx < c.C * 8; idx += NTHREADS) { const int j = idx >> 3, d = (idx & 7) * 8;
        rot_piece(P + (size_t)(c.row0 + j) * NPROJ + 512 + h * 128, rot + (size_t)(c.rot0 + j) * 128, d, 0.08838834764831845f * __expf(lg * (float)(c.C - 1 - j)), Kd, j); }
    for (int idx = X.tid; idx < c.C * 16; idx += NTHREADS) { const int j = idx >> 4, o = (idx & 15) * 8;
        *(LAS u32x4*)(Vs + j * LD136 + o * 2) = *(const u32x4*)(P + (size_t)(c.row0 + j) * NPROJ + 1024 + h * 128 + o); }
    __syncthreads();
    f32x4 acc[8];
#pragma unroll
    for (int t = 0; t < 8; ++t) acc[t] = (f32x4){0.f, 0.f, 0.f, 0.f};
    for (int ks = 0; ks < c.C / 32; ++ks) { const bf16x8 a = lds_trfrag(Kd, LD136, 32 * ks, 16 * X.wave, X.lane);
#pragma unroll
        for (int t = 0; t < 8; ++t) acc[t] = mfma16(a, lds_trfrag(Vs, LD136, 32 * ks, 16 * t, X.lane), acc[t]); }
    float* U = (float*)(X.ws + WS_U) + (size_t)(ck * 4 + h) * 16384;
#pragma unroll
    for (int t = 0; t < 8; ++t)
#pragma unroll
        for (int r = 0; r < 4; ++r) U[(16 * X.wave + 4 * (X.lane >> 4) + r) * 128 + 16 * t + (X.lane & 15)] = acc[t][r];
    __syncthreads();
}
DEV void conv16(const Ctx& X, const Chunk& c, int l, int t, int pcol, const float* state, int swidth, int scol, const float* cw, int cws, float (&y)[16]) {
    const bf16* P = (const bf16*)(X.ws + WS_HP);
#pragma unroll
    for (int i = 0; i < 16; ++i) y[i] = 0.f;
#pragma unroll
    for (int j = 0; j < 4; ++j) { const int tt = t - 3 + j; float xr[16];
        if (tt >= 0 || (!c.sample && c.n > 0)) { const bf16* src = P + (size_t)(c.row0 + tt) * NPROJ + pcol; unpack8(*(const u32x4*)src, xr); unpack8(*(const u32x4*)(src + 8), xr + 8); }
        else if (c.sample) { const f32x4* s = (const f32x4*)(state + ((size_t)(l * DB + c.stream) * 3 + (3 + tt)) * swidth + scol);
#pragma unroll
            for (int i = 0; i < 4; ++i) { const f32x4 v = s[i]; xr[4 * i] = v.x; xr[4 * i + 1] = v.y; xr[4 * i + 2] = v.z; xr[4 * i + 3] = v.w; } }
        else {
#pragma unroll
            for (int i = 0; i < 16; ++i) xr[i] = 0.f; }
        const f32x4* w4 = (const f32x4*)(cw + (size_t)j * cws);
#pragma unroll
        for (int i = 0; i < 4; ++i) { const f32x4 w = w4[i]; y[4 * i] += w.x * xr[4 * i]; y[4 * i + 1] += w.y * xr[4 * i + 1]; y[4 * i + 2] += w.z * xr[4 * i + 2]; y[4 * i + 3] += w.w * xr[4 * i + 3]; } }
}
template <int C> DEV void dn_solve(const Ctx& X, const Chunk& c, int h, LAS float* RHS, LAS float* Am) {
    if (X.tid < 256) { const int col = X.tid; float x[C];
#pragma unroll
        for (int i = 0; i < C; ++i) { float a = RHS[i * 260 + col];
#pragma unroll
            for (int j = 0; j < i; ++j) a -= Am[i * 64 + j] * x[j];
            x[i] = a; }
        bf16* dst = (bf16*)(X.ws + (col < 128 ? WS_DNU : WS_DNW)) + (size_t)c.row0 * 512 + h * 128 + (col & 127);
#pragma unroll
        for (int i = 0; i < C; ++i) dst[(size_t)i * 512] = (bf16)f2bf(x[i]); }
}
DEV void dn_prep_unit(const Ctx& X, int l, int ck, int h) {
    const Chunk c = chunk_of(ck); const int unit = ck * 4 + h; const float* gab = (const float*)(X.ws + WS_GAB);
    LAS unsigned char* Qs = X.lds; LAS unsigned char* Ks = X.lds + 17408; LAS float* RHS = (LAS float*)(X.lds + 34816); LAS float* Am = (LAS float*)(X.lds + 101376);
    LAS float* sG = (LAS float*)(X.lds + 117760); LAS float* sB = sG + 64; LAS float* sGC = sG + 128;
    if (X.tid < c.C) { const int row = c.row0 + X.tid;
        sG[X.tid] = -__expf(INP(I_DALOG)[l * 4 + h]) * softplusf_(gab[(size_t)row * 8 + h] + INP(I_DDT)[l * 4 + h]); sB[X.tid] = sigmoidf_(gab[(size_t)row * 8 + 4 + h]); }
    __syncthreads();
    if (X.tid < c.C) { float s = 0.f; for (int i = 0; i <= X.tid; ++i) s += sG[i]; sGC[X.tid] = s; }
    __syncthreads();
    { const int t0 = X.tid >> 3, part = X.tid & 7, t = t0 < c.C ? t0 : c.C - 1; const bool valid = t0 < c.C; const int row = c.row0 + t;
      const float beta = sB[t], gc = sGC[t], gl = sGC[c.C - 1], egc = __expf(gc), ekd = __expf(gl - gc);
      const float* cw = INP(I_DCW) + (size_t)l * 4 * 1536;
#pragma unroll 1
      for (int mm = 0; mm < 3; ++mm) {
          const int cc = mm * 512 + h * 128 + 16 * part; float y[16];
          conv16(X, c, l, t, 4096 + cc, INP(I_SDC), 1536, cc, cw + cc, 1536, y);
#pragma unroll
          for (int i = 0; i < 16; ++i) y[i] = siluf_(y[i]);
          if (mm < 2) { float ss = 0.f;
#pragma unroll
              for (int i = 0; i < 16; ++i) ss += y[i] * y[i];
              ss += SHFL_XOR(ss, 1); ss += SHFL_XOR(ss, 2); ss += SHFL_XOR(ss, 4);
              const float rn = (mm == 0 ? 0.08838834764831845f : 1.f) / sqrtf(ss + 1e-6f);
#pragma unroll
              for (int i = 0; i < 16; ++i) y[i] *= rn; }
          if (valid) {
              if (mm == 0) { float qd[16];
#pragma unroll
                  for (int i = 0; i < 16; ++i) qd[i] = y[i] * egc;
                  *(LAS u32x4*)(Qs + t * LD136 + part * 32) = pack8(y); *(LAS u32x4*)(Qs + t * LD136 + part * 32 + 16) = pack8(y + 8);
                  bf16* dq = (bf16*)(X.ws + WS_DNQ) + (size_t)row * 512 + h * 128 + 16 * part; *(u32x4*)dq = pack8(qd); *(u32x4*)(dq + 8) = pack8(qd + 8); }
              else if (mm == 1) {
                  *(LAS u32x4*)(Ks + t * LD136 + part * 32) = pack8(y); *(LAS u32x4*)(Ks + t * LD136 + part * 32 + 16) = pack8(y + 8);
                  bf16* dk = (bf16*)(X.ws + WS_DNK) + (size_t)unit * 8192 + (size_t)(16 * part) * 64 + t;
#pragma unroll
                  for (int i = 0; i < 16; ++i) { dk[i * 64] = (bf16)f2bf(y[i] * ekd); RHS[t * 260 + 128 + 16 * part + i] = beta * egc * y[i]; } }
              else {
#pragma unroll
                  for (int i = 0; i < 16; ++i) RHS[t * 260 + 16 * part + i] = beta * y[i]; } } }
      if (X.tid == 0) ((float*)(X.ws + WS_DNGL))[unit] = gl; }
    __syncthreads();
    { const int nt = c.C / 16; bf16* attn = (bf16*)(X.ws + WS_DNA) + (size_t)unit * 4096;
      for (int tt = X.wave; tt < 2 * nt * nt; tt += NWAVES) { const int which = tt / (nt * nt), it = (tt % (nt * nt)) / nt, jt = tt % nt;
          f32x4 acc = (f32x4){0.f, 0.f, 0.f, 0.f};
          if (jt <= it) {
#pragma unroll
              for (int ks = 0; ks < 4; ++ks) acc = mfma16(lds_rowfrag(which ? Qs : Ks, LD136, 16 * it, 32 * ks, X.lane), lds_rowfrag(Ks, LD136, 16 * jt, 32 * ks, X.lane), acc); }
          const int j = 16 * jt + (X.lane & 15); const float gcj = sGC[j];
#pragma unroll
          for (int r = 0; r < 4; ++r) { const int i = 16 * it + 4 * (X.lane >> 4) + r; const float dec = __expf(fminf(sGC[i] - gcj, 0.f));
              if (which == 0) Am[i * 64 + j] = (j < i) ? sB[i] * acc[r] * dec : 0.f;
              else attn[i * 64 + j] = (bf16)((j <= i) ? f2bf(acc[r] * dec) : 0u); } } }
    __syncthreads();
    if (c.C == 64) dn_solve<64>(X, c, h, RHS, Am); else dn_solve<32>(X, c, h, RHS, Am);
    __syncthreads();
}
DEV void lru_prep_unit(const Ctx& X, int l, int ck, int q4) {
    const Chunk c = chunk_of(ck); const int c0 = q4 * 128;
    LAS float* XC = (LAS float*)X.lds; LAS unsigned char* XCb = X.lds + 33792; LAS float* AA = (LAS float*)(X.lds + 51200);
    { const int t0 = X.tid >> 3, part = X.tid & 7; if (t0 < c.C) { const int t = t0, cc = c0 + 16 * part; float y[16]; conv16(X, c, l, t, 2560 + cc, INP(I_SLC), 512, cc, INP(I_LCW) + (size_t)l * 4 * 512 + cc, 512, y);
          const float* cb = INP(I_LCB) + (size_t)l * 512;
#pragma unroll
          for (int i = 0; i < 16; ++i) { y[i] += cb[cc + i]; XC[t * 132 + 16 * part + i] = y[i]; }
          *(LAS u32x4*)(XCb + t * LD136 + part * 32) = pack8(y); *(LAS u32x4*)(XCb + t * LD136 + part * 32 + 16) = pack8(y + 8); } }
    __syncthreads();
    { const bf16* WT = (const bf16*)(X.ws + WS_LRUW) + (size_t)l * 2 * 8 * 4096; const int ct = X.wave, hb = 2 * q4 + (ct >> 2), j0 = 16 * (ct & 3);
      const int cl = 16 * ct + (X.lane & 15), cg = c0 + cl;
      const float ba = INP(I_LBA)[l * 512 + cg], bx = INP(I_LBX)[l * 512 + cg], spl = softplusf_(-INP(I_LAM)[l * 512 + cg]);
      for (int rt = 0; rt < c.C / 16; ++rt) { f32x4 aR = (f32x4){0.f, 0.f, 0.f, 0.f}, aI = aR;
#pragma unroll
          for (int ks = 0; ks < 2; ++ks) { const bf16x8 a = lds_rowfrag(XCb, LD136, 16 * rt, (ct >> 2) * 64 + 32 * ks, X.lane);
              aR = mfma16(a, glb_rowfrag(WT + (size_t)hb * 4096, 64, j0, 32 * ks, X.lane), aR); aI = mfma16(a, glb_rowfrag(WT + (size_t)(8 + hb) * 4096, 64, j0, 32 * ks, X.lane), aI); }
#pragma unroll
          for (int r = 0; r < 4; ++r) { const int t = 16 * rt + 4 * (X.lane >> 4) + r; const float rr = sigmoidf_(aR[r] + ba), ii = sigmoidf_(aI[r] + bx);
              const float la = -8.f * rr * spl, a = __expf(la), bb = sqrtf(-expm1f(2.f * la)) * (ii * XC[t * 132 + cl]); AA[t * 132 + cl] = a; XC[t * 132 + cl] = bb; } } }
    __syncthreads();
    if (X.tid < 128) { const int cl = X.tid; float hl = 0.f, ac = 1.f; float* LRH = (float*)(X.ws + WS_LRH); float* LRA = (float*)(X.ws + WS_LRA);
        for (int t = 0; t < c.C; ++t) { const float a = AA[t * 132 + cl], bb = XC[t * 132 + cl]; hl = a * hl + bb; ac *= a; LRH[(size_t)(c.row0 + t) * 512 + c0 + cl] = hl; LRA[(size_t)(c.row0 + t) * 512 + c0 + cl] = ac; } }
    else if (X.tid < 512 && (c.sample || c.n == NCH - 1)) {
        const int e = X.tid - 128, tt = e >> 7, cl = e & 127; const bf16* P = (const bf16*)(X.ws + WS_HP);
        const float v = bf2f(P[(size_t)(c.row0 + c.C - 3 + tt) * NPROJ + 2560 + c0 + cl]);
        float* o = X.out + (c.sample ? O_LCS + ((size_t)(l * DB + c.stream) * 3 + tt) * 512 : O_LCP + ((size_t)(l * BATCH + c.stream) * 3 + tt) * 512) + c0 + cl; *o = v; }
    __syncthreads();
}
DEV void sg_ln_rows(const Ctx& X, int l) {
    const bf16* P = (const bf16*)(X.ws + WS_HP); bf16* VN = (bf16*)(X.ws + WS_VN); const float* g = INP(I_SGG) + l * 512; const float* b = INP(I_SGB) + l * 512;
    for (int row = X.gw; row < M; row += X.NGW) { float v[8]; unpack8(*(const u32x4*)(P + (size_t)row * NPROJ + 3584 + 8 * X.lane), v); float s = 0.f;
#pragma unroll
        for (int i = 0; i < 8; ++i) { v[i] = geluf_(v[i]); s += v[i]; }
        const float mean = wave_sum(s) * (1.f / 512.f); float s2 = 0.f;
#pragma unroll
        for (int i = 0; i < 8; ++i) { v[i] -= mean; s2 += v[i] * v[i]; }
        const float rstd = 1.f / sqrtf(wave_sum(s2) * (1.f / 512.f) + LN_EPS);
#pragma unroll
        for (int i = 0; i < 8; ++i) v[i] = v[i] * rstd * g[8 * X.lane + i] + b[8 * X.lane + i];
        *(u32x4*)(VN + (size_t)row * 512 + 8 * X.lane) = pack8(v);
        if (row >= MP) { float* o = X.out + O_SGV + ((size_t)l * MS + (row - MP)) * 512 + 8 * X.lane; *(f32x4*)o = (f32x4){v[0], v[1], v[2], v[3]}; *(f32x4*)(o + 4) = (f32x4){v[4], v[5], v[6], v[7]}; } }
}

DEV void dn_seq_unit(const Ctx& X, int l, bool sample, int stream, int h, int s4) {
    LAS unsigned char* ST = X.lds; LAS unsigned char* VT = X.lds + 8704;
    const int w = X.wave, lane = X.lane, g = lane >> 4, lc = lane & 15, it = w & 3, et = w >> 2;
    const int C = sample ? 32 : 64, nsteps = sample ? 1 : NCH; const bool v12 = it < C / 16;
    f32x4 S[2];
    if (sample) { const float* s0 = INP(I_SDN) + ((size_t)(l * DB + stream) * 4 + h) * 16384;
#pragma unroll
        for (int t = 0; t < 2; ++t)
#pragma unroll
            for (int r = 0; r < 4; ++r) S[t][r] = s0[(16 * w + 4 * g + r) * 128 + 32 * s4 + 16 * t + lc]; }
    else { S[0] = (f32x4){0.f, 0.f, 0.f, 0.f}; S[1] = S[0]; }
    const bf16* DNU = (const bf16*)(X.ws + WS_DNU); const bf16* DNW = (const bf16*)(X.ws + WS_DNW); const bf16* DNQ = (const bf16*)(X.ws + WS_DNQ);
    const bf16* DNK = (const bf16*)(X.ws + WS_DNK); const bf16* DNA = (const bf16*)(X.ws + WS_DNA); const float* DNGL = (const float*)(X.ws + WS_DNGL); float* DNO = (float*)(X.ws + WS_DNO);
    for (int n = 0; n < nsteps; ++n) {
        const int ck = sample ? NPCH + stream : stream * NCH + n, unit = ck * 4 + h, row0 = sample ? MP + 32 * stream : ck * 64;
#pragma unroll
        for (int t = 0; t < 2; ++t) { u32x2 p; p.x = pk2(S[t][0], S[t][1]); p.y = pk2(S[t][2], S[t][3]); *(LAS u32x2*)(ST + (16 * t + lc) * LD136 + (16 * w + 4 * g) * 2) = p; }
        bf16x8 wf[4], qf[4], af[2], kf[2]; float uu[4];
        const int ri = v12 ? 16 * it : 0;
#pragma unroll
        for (int ks = 0; ks < 4; ++ks) { wf[ks] = glb_rowfrag(DNW + (size_t)row0 * 512 + h * 128, 512, ri, 32 * ks, lane); qf[ks] = glb_rowfrag(DNQ + (size_t)row0 * 512 + h * 128, 512, ri, 32 * ks, lane); }
#pragma unroll
        for (int ks = 0; ks < 2; ++ks) { const int k0 = (ks < C / 32) ? 32 * ks : 0; af[ks] = glb_rowfrag(DNA + (size_t)unit * 4096, 64, ri, k0, lane); kf[ks] = glb_rowfrag(DNK + (size_t)unit * 8192, 64, 16 * w, k0, lane); }
#pragma unroll
        for (int r = 0; r < 4; ++r) uu[r] = bf2f(DNU[(size_t)(row0 + ri + 4 * g + r) * 512 + h * 128 + 32 * s4 + 16 * et + lc]);
        const float eg = __expf(DNGL[unit]);
        __syncthreads();
        f32x4 vn = (f32x4){0.f, 0.f, 0.f, 0.f};
        if (v12) {
#pragma unroll
            for (int ks = 0; ks < 4; ++ks) vn = mfma16(wf[ks], lds_rowfrag(ST, LD136, 16 * et, 32 * ks, lane), vn);
#pragma unroll
            for (int r = 0; r < 4; ++r) vn[r] = uu[r] - vn[r];
            u32x2 p; p.x = pk2(vn[0], vn[1]); p.y = pk2(vn[2], vn[3]); *(LAS u32x2*)(VT + (16 * et + lc) * LD72 + (16 * it + 4 * g) * 2) = p; }
        __syncthreads();
        if (v12) { f32x4 o = (f32x4){0.f, 0.f, 0.f, 0.f};
#pragma unroll
            for (int ks = 0; ks < 4; ++ks) o = mfma16(qf[ks], lds_rowfrag(ST, LD136, 16 * et, 32 * ks, lane), o);
            for (int ks = 0; ks < C / 32; ++ks) o = mfma16(af[ks], lds_rowfrag(VT, LD72, 16 * et, 32 * ks, lane), o);
#pragma unroll
            for (int r = 0; r < 4; ++r) DNO[(size_t)(row0 + 16 * it + 4 * g + r) * 512 + h * 128 + 32 * s4 + 16 * et + lc] = o[r]; }
#pragma unroll
        for (int t = 0; t < 2; ++t) { S[t] = S[t] * eg; for (int ks = 0; ks < C / 32; ++ks) S[t] = mfma16(kf[ks], lds_rowfrag(VT, LD72, 16 * t, 32 * ks, lane), S[t]); }
        __syncthreads();
    }
    float* so = X.out + (sample ? O_DNS + ((size_t)(l * DB + stream) * 4 + h) * 16384 : O_DNP + ((size_t)(l * BATCH + stream) * 4 + h) * 16384);
#pragma unroll
    for (int t = 0; t < 2; ++t)
#pragma unroll
        for (int r = 0; r < 4; ++r) so[(16 * w + 4 * g + r) * 128 + 32 * s4 + 16 * t + lc] = S[t][r];
}
DEV void ret_scan_job(const Ctx& X, int l, int job) {
    const int sh = job >> 2, q = job & 3, e0 = q * 4096 + X.tid * 8; float* U = (float*)(X.ws + WS_U);
    if (sh < BATCH * 4) { const int b = sh >> 2, h = sh & 3; const float gC = __expf(ret_log_g(h) * 64.f); f32x4 r0 = (f32x4){0.f, 0.f, 0.f, 0.f}, r1 = r0;
        for (int n = 0; n < NCH; ++n) { float* p = U + (size_t)((b * NCH + n) * 4 + h) * 16384 + e0; const f32x4 u0 = *(f32x4*)p, u1 = *(f32x4*)(p + 4); *(f32x4*)p = r0; *(f32x4*)(p + 4) = r1; r0 = r0 * gC + u0; r1 = r1 * gC + u1; }
        float* o = X.out + O_RETP + ((size_t)(l * BATCH + b) * 4 + h) * 16384 + e0; *(f32x4*)o = r0; *(f32x4*)(o + 4) = r1; }
    else { const int sb = (sh - BATCH * 4) >> 2, h = sh & 3; const float gC = __expf(ret_log_g(h) * 32.f); const float* s0 = INP(I_SRET) + ((size_t)(l * DB + sb) * 4 + h) * 16384 + e0;
        float* p = U + (size_t)((NPCH + sb) * 4 + h) * 16384 + e0; const f32x4 a0 = *(const f32x4*)s0, a1 = *(const f32x4*)(s0 + 4), u0 = *(f32x4*)p, u1 = *(f32x4*)(p + 4);
        *(f32x4*)p = a0; *(f32x4*)(p + 4) = a1; float* o = X.out + O_RETS + ((size_t)(l * DB + sb) * 4 + h) * 16384 + e0; *(f32x4*)o = a0 * gC + u0; *(f32x4*)(o + 4) = a1 * gC + u1; }
}
DEV void lru_scan_job(const Ctx& X, int l, int job) {
    const float* LRA = (const float*)(X.ws + WS_LRA); const float* LRH = (const float*)(X.ws + WS_LRH); const int ch = X.tid;
    if (job < BATCH) { const int b = job; float carry = 0.f; float* LRC = (float*)(X.ws + WS_LRC);
        for (int n = 0; n < NCH; ++n) { const int ck = b * NCH + n; LRC[(size_t)ck * 512 + ch] = carry; const size_t last = (size_t)(ck * 64 + 63) * 512 + ch; carry = LRA[last] * carry + LRH[last]; }
        X.out[O_LHP + (size_t)(l * BATCH + b) * 512 + ch] = carry; }
    else { const int sb = job - BATCH; const size_t last = (size_t)(MP + 32 * sb + 31) * 512 + ch; X.out[O_LHS + (size_t)(l * DB + sb) * 512 + ch] = LRA[last] * INP(I_SLH)[(size_t)(l * DB + sb) * 512 + ch] + LRH[last]; }
}
DEV void sg_out_job(const Ctx& X, int l, int job) {
    int row0, C, h; if (job < BATCH * (SEQ / 128) * 4) { h = job & 3; row0 = (job >> 2) * 128; C = 128; } else { const int j2 = job - BATCH * (SEQ / 128) * 4; h = j2 & 3; row0 = MP + 32 * (j2 >> 2); C = 32; }
    const bf16* VN = (const bf16*)(X.ws + WS_VN); const bf16* P = (const bf16*)(X.ws + WS_HP); bf16* MRG = (bf16*)(X.ws + WS_MRG);
    const bf16* Wm = (const bf16*)(X.ws + WS_SGW) + (size_t)(l * 4 + h) * 16384; LAS unsigned char* Vs = X.lds;
    for (int idx = X.tid; idx < C * 16; idx += NTHREADS) { const int j = idx >> 4, o = (idx & 15) * 8; *(LAS u32x4*)(Vs + j * LD136 + o * 2) = *(const u32x4*)(VN + (size_t)(row0 + j) * 512 + h * 128 + o); }
    __syncthreads();
    for (int it = X.wave; it < C / 16; it += NWAVES) { f32x4 acc[8];
#pragma unroll
        for (int t = 0; t < 8; ++t) acc[t] = (f32x4){0.f, 0.f, 0.f, 0.f};
        const int nks = (C == 128 && it < 4) ? 2 : C / 32;
        for (int ks = 0; ks < nks; ++ks) { const bf16x8 a = glb_rowfrag(Wm, 128, 16 * it, 32 * ks, X.lane);
#pragma unroll
            for (int t = 0; t < 8; ++t) acc[t] = mfma16(a, lds_trfrag(Vs, LD136, 32 * ks, 16 * t, X.lane), acc[t]); }
#pragma unroll
        for (int r = 0; r < 4; ++r) { const int i = 16 * it + 4 * (X.lane >> 4) + r; const float bs = INP(I_SGBS)[(size_t)(l * 4 + h) * 128 + i];
#pragma unroll
            for (int t = 0; t < 8; ++t) { const int e = 16 * t + (X.lane & 15); const float cu = bf2f(P[(size_t)(row0 + i) * NPROJ + 3072 + h * 128 + e]);
                MRG[(size_t)(row0 + i) * D + 1024 + h * 128 + e] = (bf16)f2bf(geluf_(cu) * (acc[t][r] + bs)); } } }
    __syncthreads();
}

DEV void ret_out_unit(const Ctx& X, int l, int ck, int h) {
    const Chunk c = chunk_of(ck); const bf16* P = (const bf16*)(X.ws + WS_HP); const float* rot = (const float*)(X.ws + WS_ROT); const float lg = ret_log_g(h);
    LAS unsigned char* Qs = X.lds; LAS unsigned char* Ks = X.lds + 17408; LAS unsigned char* Vs = X.lds + 34816; LAS unsigned char* Ss = X.lds + 52224; LAS unsigned char* Ps = X.lds + 87040; LAS float* Os = (LAS float*)(X.lds + 96256);
    for (int idx = X.tid; idx < c.C * 8; idx += NTHREADS) { const int j = idx >> 3, d = (idx & 7) * 8; const bf16* pr = P + (size_t)(c.row0 + j) * NPROJ + h * 128; const float* rr = rot + (size_t)(c.rot0 + j) * 128;
        rot_piece(pr, rr, d, 1.f, Qs, j); rot_piece(pr + 512, rr, d, 0.08838834764831845f, Ks, j); }
    for (int idx = X.tid; idx < c.C * 16; idx += NTHREADS) { const int j = idx >> 4, o = (idx & 15) * 8; *(LAS u32x4*)(Vs + j * LD136 + o * 2) = *(const u32x4*)(P + (size_t)(c.row0 + j) * NPROJ + 1024 + h * 128 + o); }
    { const float* U = (const float*)(X.ws + WS_U) + (size_t)(ck * 4 + h) * 16384;
      for (int idx = X.tid; idx < 128 * 16; idx += NTHREADS) { const int d = idx >> 4, o = (idx & 15) * 8; const f32x4 a = *(const f32x4*)(U + d * 128 + o), b = *(const f32x4*)(U + d * 128 + o + 4);
          u32x4 p; p.x = pk2(a.x, a.y); p.y = pk2(a.z, a.w); p.z = pk2(b.x, b.y); p.w = pk2(b.z, b.w); *(LAS u32x4*)(Ss + d * LD136 + o * 2) = p; } }
    __syncthreads();
    { const int nt = c.C / 16;
      for (int tt = X.wave; tt < nt * nt; tt += NWAVES) { const int it = tt / nt, jt = tt % nt; f32x4 acc = (f32x4){0.f, 0.f, 0.f, 0.f};
          if (jt <= it) {
#pragma unroll
              for (int ks = 0; ks < 4; ++ks) acc = mfma16(lds_rowfrag(Qs, LD136, 16 * it, 32 * ks, X.lane), lds_rowfrag(Ks, LD136, 16 * jt, 32 * ks, X.lane), acc); }
          const int j = 16 * jt + (X.lane & 15);
#pragma unroll
          for (int r = 0; r < 4; ++r) { const int i = 16 * it + 4 * (X.lane >> 4) + r; *(LAS bf16*)(Ps + i * LD72 + j * 2) = (bf16)((j <= i) ? f2bf(acc[r] * __expf(lg * (float)(i - j))) : 0u); } } }
    __syncthreads();
    { const int et = X.wave;
      for (int it = 0; it < c.C / 16; ++it) { f32x4 acc = (f32x4){0.f, 0.f, 0.f, 0.f};
#pragma unroll
          for (int ks = 0; ks < 4; ++ks) acc = mfma16(lds_rowfrag(Qs, LD136, 16 * it, 32 * ks, X.lane), lds_trfrag(Ss, LD136, 32 * ks, 16 * et, X.lane), acc);
#pragma unroll
          for (int r = 0; r < 4; ++r) acc[r] *= __expf(lg * (float)(16 * it + 4 * (X.lane >> 4) + r + 1));
          for (int ks = 0; ks < c.C / 32; ++ks) acc = mfma16(lds_rowfrag(Ps, LD72, 16 * it, 32 * ks, X.lane), lds_trfrag(Vs, LD136, 32 * ks, 16 * et, X.lane), acc);
#pragma unroll
          for (int r = 0; r < 4; ++r) Os[(16 * it + 4 * (X.lane >> 4) + r) * 132 + 16 * et + (X.lane & 15)] = acc[r]; } }
    __syncthreads();
    { const int t0 = X.tid >> 3, part = X.tid & 7, t = t0 < c.C ? t0 : c.C - 1; float o[16]; float s = 0.f;
#pragma unroll
      for (int i = 0; i < 16; ++i) { o[i] = Os[t * 132 + 16 * part + i]; s += o[i]; }
      s += SHFL_XOR(s, 1); s += SHFL_XOR(s, 2); s += SHFL_XOR(s, 4); const float mean = s * (1.f / 128.f); float s2 = 0.f;
#pragma unroll
      for (int i = 0; i < 16; ++i) { o[i] -= mean; s2 += o[i] * o[i]; }
      s2 += SHFL_XOR(s2, 1); s2 += SHFL_XOR(s2, 2); s2 += SHFL_XOR(s2, 4); const float rstd = 1.f / sqrtf(s2 * (1.f / 128.f) + LN_EPS);
      if (t0 < c.C) { const int row = c.row0 + t, cc = h * 128 + 16 * part; float ag[16]; const bf16* pg = P + (size_t)row * NPROJ + 1536 + cc; unpack8(*(const u32x4*)pg, ag); unpack8(*(const u32x4*)(pg + 8), ag + 8);
          const float* gn = INP(I_RETG) + l * 512 + cc;
#pragma unroll
          for (int i = 0; i < 16; ++i) o[i] = o[i] * rstd * gn[i] * siluf_(ag[i]);
          bf16* dst = (bf16*)(X.ws + WS_MRG) + (size_t)row * D + cc; *(u32x4*)dst = pack8(o); *(u32x4*)(dst + 8) = pack8(o + 8); } }
    __syncthreads();
}
DEV void m3_rows(const Ctx& X, int l) {
    const bf16* P = (const bf16*)(X.ws + WS_HP); bf16* MRG = (bf16*)(X.ws + WS_MRG); const float* LRA = (const float*)(X.ws + WS_LRA); const float* LRH = (const float*)(X.ws + WS_LRH);
    const float* LRC = (const float*)(X.ws + WS_LRC); const float* DNO = (const float*)(X.ws + WS_DNO); const int c8 = 8 * X.lane;
    for (int row = X.gw; row < M; row += X.NGW) {
        { const float* cr = row < MP ? LRC + (size_t)(row >> 6) * 512 + c8 : INP(I_SLH) + (size_t)(l * DB + ((row - MP) >> 5)) * 512 + c8; float by[8], o[8]; unpack8(*(const u32x4*)(P + (size_t)row * NPROJ + 2048 + c8), by);
#pragma unroll
          for (int i = 0; i < 8; ++i) o[i] = (LRA[(size_t)row * 512 + c8 + i] * cr[i] + LRH[(size_t)row * 512 + c8 + i]) * geluf_(by[i]);
          *(u32x4*)(MRG + (size_t)row * D + 512 + c8) = pack8(o); }
        { float o[8], z[8]; float ss = 0.f; unpack8(*(const u32x4*)(P + (size_t)row * NPROJ + 5632 + c8), z);
#pragma unroll
          for (int i = 0; i < 8; ++i) { o[i] = DNO[(size_t)row * 512 + c8 + i]; ss += o[i] * o[i]; }
          ss += SHFL_XOR(ss, 1); ss += SHFL_XOR(ss, 2); ss += SHFL_XOR(ss, 4); ss += SHFL_XOR(ss, 8); const float rms = 1.f / sqrtf(ss * (1.f / 128.f) + LN_EPS);
          const float* gn = INP(I_DNG) + l * 128 + (c8 & 127);
#pragma unroll
          for (int i = 0; i < 8; ++i) o[i] = o[i] * rms * gn[i] * siluf_(z[i]);
          *(u32x4*)(MRG + (size_t)row * D + 1536 + c8) = pack8(o); } }
    { const size_t gt = (size_t)X.wg * NTHREADS + X.tid, GT = (size_t)X.G * NTHREADS;
      for (size_t i = gt; i < (size_t)(BATCH + DB) * 3 * 1536; i += GT) { const int cc = (int)(i % 1536), tt = (int)((i / 1536) % 3), s = (int)(i / 4608);
          if (s < BATCH) X.out[O_DCP + ((size_t)(l * BATCH + s) * 3 + tt) * 1536 + cc] = bf2f(P[(size_t)(s * SEQ + SEQ - 3 + tt) * NPROJ + 4096 + cc]);
          else X.out[O_DCS + ((size_t)(l * DB + (s - BATCH)) * 3 + tt) * 1536 + cc] = bf2f(P[(size_t)(MP + 32 * (s - BATCH) + 29 + tt) * NPROJ + 4096 + cc]); } }
}

#ifndef MK_PER_PHASE
#define MK_PER_PHASE 0
#endif
constexpr int NPHASE = 26;
#define IN(k) (lo <= (k) && (k) < hi)
#define SEAM(k) do { if (!MK_PER_PHASE && IN((k) + 1)) xcd_barrier(bar); } while (0)
template <int l> DEV void layer_phases(const Ctx& X, const XcdBarrier& bar, const int lo, const int hi) {
    bf16* XB = (bf16*)(X.ws + WS_XB); float* XC = (float*)(X.ws + WS_XC); float* Z = (float*)(X.ws + WS_Z); bf16* HB = (bf16*)(X.ws + WS_HP); bf16* MRG = (bf16*)(X.ws + WS_MRG);
        const int pb = 1 + 13 * l;
        const float* xres_p = l == 0 ? INP(I_XP) : XC; const float* xres_s = l == 0 ? INP(I_XS) : XC + (size_t)MP * D;
        if (IN(pb + 0)) { pg8::Gemm g{XB, (const bf16*)(X.ws + WS_W1I), M, 2 * FF, D}; pg8::StaticOrder S; S.init(M, 2 * FF, X.G, X.wg); EpiSwiglu E{HB};
            pg8::gemm_phase<EpiSwiglu, pg8::StaticOrder, true, true>(X.lds, g, S, E); SEAM(pb + 0); }
        if (IN(pb + 1)) { pg8::Gemm g{HB, (const bf16*)(X.ws + WS_W1O), M, D, FF}; pg8::StaticOrder S; S.init(M, D, X.G, X.wg); EpiResid E{xres_p, xres_s, Z, 0.5f};
            pg8::gemm_phase<EpiResid, pg8::StaticOrder, true, true>(X.lds, g, S, E); SEAM(pb + 1); }
        if (IN(pb + 2)) { ln_phase(X, INP(I_LN1G) + l * D, INP(I_LN1B) + l * D, XC, true); SEAM(pb + 2); }
        if (IN(pb + 3)) { pg8::Gemm g{XB, (const bf16*)(X.ws + WS_WMI), M, NPADW, D}; pg8::StaticOrder S; S.init(M, NPADW, X.G, X.wg); EpiProj E{HB, (float*)(X.ws + WS_GAB)};
            pg8::gemm_phase<EpiProj, pg8::StaticOrder, true, true>(X.lds, g, S, E); SEAM(pb + 3); }
        if (IN(pb + 4)) {
            sg_ln_rows(X, l);
            for (int u = X.wg; u < NCHUNK * 4; u += X.G) ret_u_unit(X, u >> 2, u & 3);
            for (int u = X.wg; u < NCHUNK * 4; u += X.G) dn_prep_unit(X, l, u >> 2, u & 3);
            for (int u = X.wg; u < NCHUNK * 4; u += X.G) lru_prep_unit(X, l, u >> 2, u & 3);
            SEAM(pb + 4); }
        if (IN(pb + 5)) {
            constexpr int NDNP = BATCH * 16, NDNS = DB * 16, NRET = (BATCH + DB) * 16, NLRU = BATCH + DB, NSGJ = BATCH * (SEQ / 128) * 4 + DB * 4, NJOB = NDNP + NDNS + NRET + NLRU + NSGJ;
            const bool dedicated = X.G > NDNP; int j0, js;
            if (dedicated && X.wg < NDNP) { j0 = X.wg; js = NJOB; } else if (dedicated) { j0 = NDNP + (X.wg - NDNP); js = X.G - NDNP; } else { j0 = X.wg; js = X.G; }
            for (int j = j0; j < NJOB; j += js) { int r = j;
                if (r < NDNP) { dn_seq_unit(X, l, false, r >> 4, (r >> 2) & 3, r & 3); continue; } r -= NDNP;
                if (r < NDNS) { dn_seq_unit(X, l, true, r >> 4, (r >> 2) & 3, r & 3); continue; } r -= NDNS;
                if (r < NRET) { ret_scan_job(X, l, r); continue; } r -= NRET;
                if (r < NLRU) { lru_scan_job(X, l, r); continue; } r -= NLRU;
                sg_out_job(X, l, r); }
            SEAM(pb + 5); }
        if (IN(pb + 6)) { for (int u = X.wg; u < NCHUNK * 4; u += X.G) ret_out_unit(X, l, u >> 2, u & 3); m3_rows(X, l); SEAM(pb + 6); }
        if (IN(pb + 7)) { pg8::Gemm g{MRG, (const bf16*)(X.ws + WS_WMO), M, D, D}; pg8::StaticOrder S; S.init(M, D, X.G, X.wg); EpiResid E{XC, XC + (size_t)MP * D, Z, 1.0f};
            pg8::gemm_phase<EpiResid, pg8::StaticOrder, true, true>(X.lds, g, S, E); SEAM(pb + 7); }
        if (IN(pb + 8)) { ln_phase(X, INP(I_LN2G) + l * D, INP(I_LN2B) + l * D, XC, true); SEAM(pb + 8); }
        if (IN(pb + 9)) { pg8::Gemm g{XB, (const bf16*)(X.ws + WS_W2I), M, 2 * FF, D}; pg8::StaticOrder S; S.init(M, 2 * FF, X.G, X.wg); EpiSwiglu E{HB};
            pg8::gemm_phase<EpiSwiglu, pg8::StaticOrder, true, true>(X.lds, g, S, E); SEAM(pb + 9); }
        if (IN(pb + 10)) { pg8::Gemm g{HB, (const bf16*)(X.ws + WS_W2O), M, D, FF}; pg8::StaticOrder S; S.init(M, D, X.G, X.wg); EpiResid E{XC, XC + (size_t)MP * D, Z, 0.5f};
            pg8::gemm_phase<EpiResid, pg8::StaticOrder, true, true>(X.lds, g, S, E); SEAM(pb + 10); }
        if (IN(pb + 11)) { ln_phase(X, INP(I_LN3G) + l * D, INP(I_LN3B) + l * D, l == DEPTH - 1 ? X.out : XC, l != DEPTH - 1); SEAM(pb + 11); }
        if (l == 0 && IN(pb + 12)) { convert_layer_weights(X, 1); SEAM(pb + 12); }
}
struct Args { const float* in[N_IN]; float* out; unsigned char* ws; int ph_lo, ph_hi; };
__global__ void __launch_bounds__(NTHREADS, 2) fwd(Args args) {
    LDS_DECL(lds);
    Ctx X; X.lds = (LAS unsigned char*)lds; X.tid = threadIdx.x; X.lane = X.tid & 63; X.wave = __builtin_amdgcn_readfirstlane(X.tid >> 6); X.wg = blockIdx.x; X.G = gridDim.x;
    X.gw = X.wg * NWAVES + X.wave; X.NGW = X.G * NWAVES; X.out = args.out; X.ws = args.ws;
    volatile LAS unsigned* MISC = (volatile LAS unsigned*)(X.lds + MISC_OFF);
    if (X.tid < 32) MISC[X.tid] = 0u;
    __syncthreads();
    XcdBarrier bar; bar.bar = (unsigned*)(X.ws + WS_CTL) + CW_BAR; bar.x = 0; bar.st = nullptr;
    if (!MK_PER_PHASE) bar = xcd_barrier_post((unsigned*)(X.ws + WS_CTL) + CW_BAR, MISC + 8);
    const int lo = args.ph_lo, hi = args.ph_hi;
    if (IN(0)) { convert_layer_weights(X, 0); prologue_misc(X); SEAM(0); }
    layer_phases<0>(X, bar, lo, hi);
    layer_phases<1>(X, bar, lo, hi);
}

extern "C" void kernel_launch(void* const* d_in, const int* in_sizes, int n_in, void* d_out, int out_size, void* d_ws, size_t ws_size, hipStream_t stream) {
    static int grid = 0;
    if (grid == 0) {
        if (n_in != N_IN || (size_t)out_size != O_END || ws_size < WS_END) { fprintf(stderr, "kernel_launch: shape mismatch: n_in %d (want %d), out %d (want %zu), ws %zu (want >= %zu); nothing launched\n", n_in, (int)N_IN, out_size, (size_t)O_END, ws_size, (size_t)WS_END); grid = -1; return; }
        int dev = 0, cus = 0, per_cu = 0;
        if (hipGetDevice(&dev) != hipSuccess || hipDeviceGetAttribute(&cus, hipDeviceAttributeMultiprocessorCount, dev) != hipSuccess) { grid = -1; return; }
        if (hipFuncSetAttribute((const void*)fwd, hipFuncAttributeMaxDynamicSharedMemorySize, LDS_BYTES) != hipSuccess) { fprintf(stderr, "kernel_launch: hipFuncSetAttribute failed\n"); grid = -1; return; }
        if (hipOccupancyMaxActiveBlocksPerMultiprocessor(&per_cu, (const void*)fwd, NTHREADS, LDS_BYTES) != hipSuccess || per_cu < 1) fprintf(stderr, "kernel_launch: occupancy query reports %d\n", per_cu);
        (void)hipGetLastError();
        grid = cus;
    }
    if (grid < 0) return;
    if (hipMemsetAsync((char*)d_ws + WS_CTL, 0, CTL_ZERO_BYTES, stream) != hipSuccess) return;
    Args a{};
    for (int i = 0; i < N_IN; ++i) a.in[i] = (const float*)d_in[i];
    a.out = (float*)d_out; a.ws = (unsigned char*)d_ws;
#ifdef HOST_EMU
    g_emu_in = (const float* const*)d_in;
#endif
#if MK_PER_PHASE
    for (int p = 0; p < NPHASE; ++p) { a.ph_lo = p; a.ph_hi = p + 1;
#ifdef HOST_EMU
        if (getenv("EMU_PH_HI") && p >= atoi(getenv("EMU_PH_HI"))) break;
        fprintf(stderr, "[emu] phase %d\n", p);
#endif
        hipLaunchKernelGGL(fwd, dim3(grid), dim3(NTHREADS), LDS_BYTES, stream, a); }
#else
    a.ph_lo = 0; a.ph_hi = NPHASE;
    hipLaunchKernelGGL(fwd, dim3(grid), dim3(NTHREADS), LDS_BYTES, stream, a);
#endif
}
#ifdef HOST_EMU
extern "C" void emu_config(int* in_sizes, int* n_in, int* out_sizes, int* n_out, size_t* ws_bytes) {
    const int G = GW; int s[N_IN] = { MP * D, MS * D, DEPTH * DB * 4 * 16384, DEPTH * DB * G, DEPTH * DB * 3 * G, DEPTH * DB * 4 * 16384, DEPTH * DB * 3 * 1536,
        DEPTH * D * 2 * FF, DEPTH * FF * D, DEPTH * D, DEPTH * D, DEPTH * D * DIN, DEPTH * G, DEPTH * 4 * G, DEPTH * G, DEPTH * 8 * 4096, DEPTH * G, DEPTH * 8 * 4096, DEPTH * G, DEPTH * G,
        DEPTH * G, DEPTH * G, DEPTH * 4 * 16384, DEPTH * 4 * 128, DEPTH * 4 * 1536, DEPTH * 4, DEPTH * 4, DEPTH * 128, DEPTH * D * D, DEPTH * D, DEPTH * D, DEPTH * D * 2 * FF, DEPTH * FF * D, DEPTH * D, DEPTH * D };
    for (int i = 0; i < N_IN; ++i) in_sizes[i] = s[i]; *n_in = N_IN;
    const size_t o[14] = { O_YP, O_YS, O_RETP, O_LHP, O_LCP, O_DNP, O_DCP, O_RETS, O_LHS, O_LCS, O_DNS, O_DCS, O_SGV, O_END };
    for (int i = 0; i < 13; ++i) out_sizes[i] = (int)(o[i + 1] - o[i]); *n_out = 13; *ws_bytes = WS_END;
}
extern "C" int emu_regions(const char** names, size_t* offs, size_t* bytes, int maxn) {
    int n = 0;
#define REG(nm, off, by) do { names[n] = nm; offs[n] = off; bytes[n] = by; ++n; } while (0)
    REG("xb", WS_XB, (size_t)M * D * 2); REG("xc", WS_XC, (size_t)M * D * 4); REG("z", WS_Z, (size_t)M * D * 4); REG("hp", WS_HP, (size_t)M * NPROJ * 2); REG("gab", WS_GAB, (size_t)M * 8 * 4);
    REG("mrg", WS_MRG, (size_t)M * D * 2); REG("w1i", WS_W1I, (size_t)2 * FF * D * 2); REG("wmi", WS_WMI, (size_t)NPADW * D * 2); REG("dno", WS_DNO, (size_t)M * 512 * 4); REG("vn", WS_VN, (size_t)M * 512 * 2);
    REG("dnu", WS_DNU, (size_t)M * 512 * 2); REG("dnw", WS_DNW, (size_t)M * 512 * 2); REG("lrh", WS_LRH, (size_t)M * 512 * 4);
#undef REG
    return n;
}
#endif
```

```cpp
#ifndef HOST_EMU
#include <hip/hip_runtime.h>
#endif
#include <cstdio>
#include <cstdint>
#include <cmath>

typedef unsigned short bf16;
typedef short bf16x8 __attribute__((ext_vector_type(8)));
typedef short s16x4 __attribute__((ext_vector_type(4)));
typedef float f32x4 __attribute__((ext_vector_type(4)));
typedef float f32x2 __attribute__((ext_vector_type(2)));
typedef unsigned u32x4 __attribute__((ext_vector_type(4)));
typedef unsigned u32x2 __attribute__((ext_vector_type(2)));
#ifdef HOST_EMU
#define LAS
#define GAS
#define WAIT_VM(n) ((void)0)
#define WAIT_LGKM(n) ((void)0)
#define SHFL_XOR(v, m) emu::shfl_xor_f((v), (m))
#define SHFL_UP(v, d) emu::shfl_up_f((v), (d))
#define DS_READ_TR16(p) emu::ds_read_tr16((const void*)(p))
#define LDS_DECL(name) unsigned char* name = emu::cur->wg->lds
#define DEV inline
#define __expf expf
#else
#define LAS __attribute__((address_space(3)))
#define GAS __attribute__((address_space(1)))
#define WAIT_VM(n) asm volatile("s_waitcnt vmcnt(" #n ")" ::: "memory")
#define WAIT_LGKM(n) asm volatile("s_waitcnt lgkmcnt(" #n ")" ::: "memory")
#define SHFL_XOR(v, m) __shfl_xor((v), (m))
#define SHFL_UP(v, d) __shfl_up((v), (d))
#define DS_READ_TR16(p) __builtin_amdgcn_ds_read_tr16_b64_v4i16((LAS s16x4*)(p))
#define LDS_DECL(name) extern __shared__ __attribute__((aligned(16))) unsigned char name[]
#define DEV __device__ __forceinline__
#endif
#define RLX_AGENT __ATOMIC_RELAXED, __HIP_MEMORY_SCOPE_AGENT
#ifdef HOST_EMU
#define NT_LOAD(p) (*(p))
#else
#define NT_LOAD(p) __builtin_nontemporal_load(p)
#endif

DEV unsigned f2bf(float f) { unsigned u = __builtin_bit_cast(unsigned, f); return (u + 0x7fffu + ((u >> 16) & 1u)) >> 16; }
DEV unsigned pk2(float lo, float hi) { return f2bf(lo) | (f2bf(hi) << 16); }
DEV float bf2f(bf16 h) { return __builtin_bit_cast(float, ((unsigned)h) << 16); }
DEV float bflo(unsigned u) { return __builtin_bit_cast(float, u << 16); }
DEV float bfhi(unsigned u) { return __builtin_bit_cast(float, u & 0xffff0000u); }
DEV f32x4 mfma16(bf16x8 a, bf16x8 b, f32x4 c) { return __builtin_amdgcn_mfma_f32_16x16x32_bf16(a, b, c, 0, 0, 0); }
DEV float sigmoidf_(float x) { return 1.f / (1.f + __expf(-x)); }
DEV float siluf_(float x) { return x / (1.f + __expf(-x)); }
DEV float geluf_(float x) { const float u = 0.7978845608028654f * (x + 0.044715f * x * x * x); return x / (1.f + __expf(-2.f * u)); }
DEV float softplusf_(float x) { return fmaxf(x, 0.f) + log1pf(__expf(-fabsf(x))); }

#ifndef CFG_BATCH
#define CFG_BATCH 4
#define CFG_SEQ 2048
#define CFG_DB 16
#define CFG_FF 5632
#endif
constexpr int D = 2048, BATCH = CFG_BATCH, SEQ = CFG_SEQ, DB = CFG_DB, DS = 32, FF = CFG_FF, DEPTH = 2, PAST = 4096;
constexpr int MP = BATCH * SEQ, MS = DB * DS, M = MP + MS;
constexpr int GW = 512;
constexpr int NPROJ = 6144, NPADW = 6400, DIN = 6152;
constexpr int NCH = SEQ / 64, NPCH = BATCH * NCH, NCHUNK = NPCH + DB;
constexpr float ALPHA = 1.4142135623730951f, LN_EPS = 1e-5f;
static_assert(MP % 256 == 0 && MS % 256 == 0 && FF % 128 == 0 && SEQ % 128 == 0, "tile divisibility");

namespace pg8 {
#define PG8_LAS LAS
typedef unsigned short bf16_t;
constexpr int BM = 256, BK = 64, HALF = 128, HTB = HALF * BK * 2  , STAGE_BYTES = 8 * HTB, NXCD = 8, WGM = 8;

__host__ __device__ __forceinline__ int lds_byte(int r, int c) { const int st = (r >> 4) * 2 + (c >> 5), rr = r & 15, cc = c & 31, ob = rr * 64 + cc * 2; return st * 1024 + (ob ^ (((ob >> 9) & 1) << 5)); }
__host__ __device__ __forceinline__ void stage_rc(int b, int& R, int& C) { const int st = b / 1024, sb = b % 1024, swz = sb ^ (((sb >> 9) & 1) << 5); R = (st >> 1) * 16 + swz / 64; C = (st & 1) * 32 + (swz % 64) / 2; }
__host__ __device__ __forceinline__ int perm32(int rho) { const int n = rho >> 4, i = rho & 15; return 8 * (i >> 2) + 4 * n + (i & 3); }

struct Unit { int pm, pn, k0; };
struct Gemm { const bf16_t* A; const bf16_t* Bt; int M, N, K, ld; };

struct StaticOrder {
    int nM, nN, nwg, G, c;
    __host__ __device__ void init(int M, int N, int G_, int c_) { nM = M / BM; nN = N / BM; nwg = nM * nN; G = G_; c = c_; }
    __host__ __device__ bool next(int i, Unit& u) const {
        const long L = (long)i * G + c; if (L >= nwg) return false;
        int wgid = (int)L; { const int q = nwg / NXCD, r = nwg % NXCD, xcd = wgid % NXCD, off = wgid / NXCD; wgid = (xcd < r ? xcd * (q + 1) : r * (q + 1) + (xcd - r) * q) + off; }
        const int nig = WGM * nN, gid = wgid / nig, fm = gid * WGM, gsz = (nM - fm) < WGM ? (nM - fm) : WGM;
        u.pm = fm + ((wgid % nig) % gsz); u.pn = (wgid % nig) / gsz; u.k0 = 0; return true;
    }
    __device__ __forceinline__ void a_ready(const Unit&) const {}
    __device__ __forceinline__ void done(const Unit&) const {}
};
struct SplitOrder {
    int G, c, pm0, nN, parts, klen, total;
    __host__ __device__ void init(int pm0_, int npan, int nN_, int parts_, int klen_, int G_, int c_) { pm0 = pm0_; nN = nN_; parts = parts_; klen = klen_; G = G_; c = c_; total = npan * nN_ * parts_; }
    __host__ __device__ bool next(int i, Unit& u) const { const long L = (long)i * G + c; if (L >= total) return false; const int part = (int)(L % parts), tile = (int)(L / parts); u.pm = pm0 + tile / nN; u.pn = tile % nN; u.k0 = part * klen; return true; }
    __device__ __forceinline__ void a_ready(const Unit&) const {}
    __device__ __forceinline__ void done(const Unit&) const {}
};

template <class Epi, class Sched, bool ALIGN_EPI = false, bool SP2 = false>
__device__ __forceinline__ void gemm_phase(PG8_LAS unsigned char* lds, const Gemm g, const Sched& S, const Epi& E) {
    const int tid = threadIdx.x, wid = __builtin_amdgcn_readfirstlane(tid >> 6), lane = tid & 63, wr = wid >> 2, wc = wid & 3, fr = lane & 15, fq = lane >> 4;
    const int K = g.K, nt = K / BK;
    unsigned voffA[2], voffB[2];
#pragma unroll
    for (int i = 0; i < 2; ++i) { int R, C; stage_rc(tid * 16 + i * 8192, R, C); const int Rb = Epi::PERM ? ((R & ~31) + perm32(R & 31)) : R;
        voffA[i] = (unsigned)(R * g.ld + C) * 2u; voffB[i] = (unsigned)(Rb * g.ld + C) * 2u; }
    const size_t kstep = (size_t)(BK * 2);
    const size_t hstep = (size_t)HALF * g.ld * 2;
    const size_t tstep = 2 * hstep;
    const unsigned ldsw = (unsigned)wid * 1024u;
    const int aoff = lds_byte(wr * 64 + fr, fq * 8), boff = lds_byte(wc * 32 + fr, fq * 8);
#define PG8_SA(b, h) (((b) * 2 + (h)) * HTB)
#define PG8_SB(b, h) ((4 + (b) * 2 + (h)) * HTB)
#define PG8_STAGE(bufoff, gbase, voff) do { _Pragma("unroll") for (int _i = 0; _i < 2; ++_i) \
        __builtin_amdgcn_global_load_lds((const unsigned*)((const char*)(gbase) + (voff)[_i]), (PG8_LAS unsigned*)(lds + (bufoff) + ldsw + _i * 8192), 16, 0, 0); } while (0)
#define PG8_LDA(dst, b, h) do { _Pragma("unroll") for (int m = 0; m < 4; ++m) _Pragma("unroll") for (int k = 0; k < 2; ++k) dst[m][k] = *(const PG8_LAS bf16x8*)(lds + PG8_SA(b, h) + aoff + m * 2048 + k * 1024); } while (0)
#define PG8_LDB(dst, b, h) do { _Pragma("unroll") for (int n = 0; n < 2; ++n) _Pragma("unroll") for (int k = 0; k < 2; ++k) dst[n][k] = *(const PG8_LAS bf16x8*)(lds + PG8_SB(b, h) + boff + n * 2048 + k * 1024); } while (0)
#define PG8_MMA(ai, bj, At, Bt) do { __builtin_amdgcn_s_setprio(1); _Pragma("unroll") for (int m = 0; m < 4; ++m) _Pragma("unroll") for (int n = 0; n < 2; ++n) _Pragma("unroll") for (int k = 0; k < 2; ++k) \
        acc[ai][bj][m][n] = __builtin_amdgcn_mfma_f32_16x16x32_bf16(Bt[n][k], At[m][k], acc[ai][bj][m][n], 0, 0, 0); __builtin_amdgcn_s_setprio(0); } while (0)
#define PG8_WAIT_V(n) WAIT_VM(n)
#define PG8_WAIT_L(n) WAIT_LGKM(n)
#define PG8_BAR __builtin_amdgcn_s_barrier()
#define PG8_SCHED __builtin_amdgcn_sched_barrier(0)
    Unit cur, nxt; int ui = 0;
    if (!S.next(0, cur)) return;
    f32x4 acc[2][2][4][2];
#pragma unroll
    for (int a = 0; a < 2; ++a)
#pragma unroll
        for (int b = 0; b < 2; ++b)
#pragma unroll
            for (int m = 0; m < 4; ++m)
#pragma unroll
                for (int n = 0; n < 2; ++n) acc[a][b][m][n] = (f32x4){0.f, 0.f, 0.f, 0.f};
    bf16x8 At[4][2], B0[2][2], B1[2][2];
    const char* cA = (const char*)g.A + (size_t)cur.pm * tstep + (size_t)cur.k0 * 2; const char* cB = (const char*)g.Bt + (size_t)cur.pn * tstep + (size_t)cur.k0 * 2;
    S.a_ready(cur);
    if constexpr (SP2) {
        PG8_STAGE(PG8_SB(0, 0), cB, voffB); PG8_STAGE(PG8_SB(0, 1), cB + hstep, voffB); PG8_STAGE(PG8_SA(0, 0), cA, voffA); PG8_STAGE(PG8_SA(0, 1), cA + hstep, voffA);
        if (wr == 1) PG8_BAR;
        PG8_WAIT_V(2); PG8_BAR;
        PG8_STAGE(PG8_SB(1, 0), cB + kstep, voffB); PG8_STAGE(PG8_SA(1, 0), cA + kstep, voffA); PG8_STAGE(PG8_SB(1, 1), cB + hstep + kstep, voffB);
        PG8_WAIT_V(6); PG8_BAR;
    } else {
        PG8_STAGE(PG8_SB(0, 0), cB, voffB); PG8_STAGE(PG8_SA(0, 0), cA, voffA); PG8_STAGE(PG8_SB(0, 1), cB + hstep, voffB); PG8_STAGE(PG8_SA(0, 1), cA + hstep, voffA);
        if (wr == 1) PG8_BAR;
        PG8_WAIT_V(4); PG8_BAR;
        PG8_STAGE(PG8_SB(1, 0), cB + kstep, voffB); PG8_STAGE(PG8_SA(1, 0), cA + kstep, voffA); PG8_STAGE(PG8_SB(1, 1), cB + hstep + kstep, voffB);
        PG8_WAIT_V(6); PG8_BAR;
    }
    for (;;) {
        const bool has_next = S.next(ui + 1, nxt);
        const char* nA = has_next ? (const char*)g.A + (size_t)nxt.pm * tstep + (size_t)nxt.k0 * 2 : cA; const char* nB = has_next ? (const char*)g.Bt + (size_t)nxt.pn * tstep + (size_t)nxt.k0 * 2 : cB;
        for (int t = 0; t < nt; t += 2) {
            const bool last = (t == nt - 2);
            const char* a1 = cA + (size_t)(t + 1) * kstep;
            const char* a2 = last ? nA : cA + (size_t)(t + 2) * kstep; const char* b2 = last ? nB : cB + (size_t)(t + 2) * kstep;
            const char* a3 = a2 + kstep; const char* b3 = b2 + kstep;
            if (last && has_next) S.a_ready(nxt);
            if constexpr (SP2) {
            PG8_LDB(B0, 0, 0); PG8_LDB(B1, 0, 1); PG8_SCHED; PG8_LDA(At, 0, 0); PG8_STAGE(PG8_SA(1, 1), a1 + hstep, voffA);
            PG8_WAIT_V(8); PG8_WAIT_L(0); PG8_BAR; PG8_MMA(0, 0, At, B0); PG8_MMA(0, 1, At, B1); PG8_BAR; PG8_SCHED;
            PG8_LDA(At, 0, 1); PG8_STAGE(PG8_SB(0, 0), b2, voffB); PG8_STAGE(PG8_SB(0, 1), b2 + hstep, voffB); PG8_STAGE(PG8_SA(0, 0), a2, voffA);
            PG8_WAIT_V(8); PG8_WAIT_L(0); PG8_BAR; PG8_MMA(1, 0, At, B0); PG8_MMA(1, 1, At, B1); PG8_BAR; PG8_SCHED;
            PG8_LDB(B0, 1, 0); PG8_LDB(B1, 1, 1); PG8_SCHED; PG8_LDA(At, 1, 0); PG8_STAGE(PG8_SA(0, 1), a2 + hstep, voffA);
            PG8_WAIT_V(8); PG8_WAIT_L(0); PG8_BAR; PG8_MMA(0, 0, At, B0); PG8_MMA(0, 1, At, B1); PG8_BAR; PG8_SCHED;
            PG8_LDA(At, 1, 1); PG8_STAGE(PG8_SB(1, 0), b3, voffB); PG8_STAGE(PG8_SB(1, 1), b3 + hstep, voffB); PG8_STAGE(PG8_SA(1, 0), a3, voffA);
            PG8_WAIT_V(8); PG8_WAIT_L(0); PG8_BAR; PG8_MMA(1, 0, At, B0); PG8_MMA(1, 1, At, B1); PG8_BAR; PG8_SCHED;
            } else {
            PG8_LDB(B0, 0, 0); PG8_SCHED; PG8_LDA(At, 0, 0); PG8_STAGE(PG8_SA(1, 1), a1 + hstep, voffA);
            PG8_WAIT_L(8); PG8_BAR; PG8_WAIT_L(0); PG8_MMA(0, 0, At, B0); PG8_BAR; PG8_SCHED;
            PG8_LDB(B1, 0, 1); PG8_STAGE(PG8_SB(0, 0), b2, voffB);
            PG8_BAR; PG8_WAIT_L(0); PG8_MMA(0, 1, At, B1); PG8_BAR;
            PG8_LDA(At, 0, 1); PG8_STAGE(PG8_SA(0, 0), a2, voffA);
            PG8_BAR; PG8_WAIT_L(0); PG8_MMA(1, 0, At, B0); PG8_BAR; PG8_SCHED;
            PG8_STAGE(PG8_SB(0, 1), b2 + hstep, voffB);
            PG8_WAIT_V(6); PG8_BAR; PG8_MMA(1, 1, At, B1); PG8_BAR;
            PG8_LDB(B0, 1, 0); PG8_SCHED; PG8_LDA(At, 1, 0); PG8_STAGE(PG8_SA(0, 1), a2 + hstep, voffA);
            PG8_WAIT_L(8); PG8_BAR; PG8_WAIT_L(0); PG8_MMA(0, 0, At, B0); PG8_BAR; PG8_SCHED;
            PG8_LDB(B1, 1, 1); PG8_STAGE(PG8_SB(1, 0), b3, voffB);
            PG8_BAR; PG8_WAIT_L(0); PG8_MMA(0, 1, At, B1); PG8_BAR;
            PG8_LDA(At, 1, 1); PG8_STAGE(PG8_SA(1, 0), a3, voffA);
            PG8_BAR; PG8_WAIT_L(0); PG8_MMA(1, 0, At, B0); PG8_BAR; PG8_SCHED;
            PG8_STAGE(PG8_SB(1, 1), b3 + hstep, voffB);
            PG8_WAIT_V(6); PG8_BAR; PG8_MMA(1, 1, At, B1); PG8_BAR;
            }
        }
        if constexpr (ALIGN_EPI) { if (wr == 0) PG8_BAR; }
        if constexpr (!Epi::AFTER_DRAIN) { E(acc, cur, wr, wc, fr, fq); S.done(cur); }
        if (!has_next) break;
#pragma unroll
        for (int a = 0; a < 2; ++a)
#pragma unroll
            for (int b = 0; b < 2; ++b)
#pragma unroll
                for (int m = 0; m < 4; ++m)
#pragma unroll
                    for (int n = 0; n < 2; ++n) acc[a][b][m][n] = (f32x4){0.f, 0.f, 0.f, 0.f};
        cur = nxt; cA = nA; cB = nB; ++ui;
        if constexpr (ALIGN_EPI) { if (wr == 1) PG8_BAR; }
    }
    PG8_WAIT_V(0);
    if constexpr (!ALIGN_EPI) { if (wr == 0) PG8_BAR; }
    PG8_BAR;
    if constexpr (Epi::AFTER_DRAIN) { E.fused(acc, cur, wr, wc, fr, fq, lds, wid, lane); S.done(cur); }
#undef PG8_SA
#undef PG8_SB
#undef PG8_STAGE
#undef PG8_LDA
#undef PG8_LDB
#undef PG8_MMA
#undef PG8_WAIT_V
#undef PG8_WAIT_L
#undef PG8_BAR
#undef PG8_SCHED
}
}

constexpr size_t al256(size_t x) { return (x + 255) & ~(size_t)255; }
constexpr size_t cmax(size_t a, size_t b) { return a > b ? a : b; }
constexpr size_t WS_CTL = 0, CTL_ZERO_BYTES = 1u << 20;
constexpr size_t WS_ROT = CTL_ZERO_BYTES;
constexpr size_t WS_LRUW = WS_ROT + al256((size_t)(SEQ + 32) * 64 * 2 * 4);
constexpr size_t WS_SGW = WS_LRUW + al256((size_t)DEPTH * 2 * 8 * 4096 * 2);
constexpr size_t WS_W1I = WS_SGW + al256((size_t)DEPTH * 4 * 16384 * 2);
constexpr size_t WS_W1O = WS_W1I + al256((size_t)2 * FF * D * 2);
constexpr size_t WS_WMI = WS_W1O + al256((size_t)D * FF * 2);
constexpr size_t WS_WMO = WS_WMI + al256((size_t)NPADW * D * 2);
constexpr size_t WS_W2I = WS_WMO + al256((size_t)D * D * 2);
constexpr size_t WS_W2O = WS_W2I + al256((size_t)2 * FF * D * 2);
constexpr size_t WS_XB = WS_W2O + al256((size_t)D * FF * 2);
constexpr size_t WS_XC = WS_XB + al256((size_t)M * D * 2);
constexpr size_t WS_Z = WS_XC + al256((size_t)M * D * 4);
constexpr size_t WS_HP = WS_Z + al256((size_t)M * D * 4);
constexpr size_t WS_GAB = WS_HP + al256(cmax((size_t)M * FF * 2, (size_t)M * NPROJ * 2));
constexpr size_t WS_MRG = WS_GAB + al256((size_t)M * 8 * 4);
constexpr size_t WS_U = WS_MRG + al256((size_t)M * D * 2);
constexpr size_t WS_DNU = WS_U + al256((size_t)NCHUNK * 4 * 16384 * 4);
constexpr size_t WS_DNW = WS_DNU + al256((size_t)M * 512 * 2);
constexpr size_t WS_DNQ = WS_DNW + al256((size_t)NCHUNK * 4 * 16384);
constexpr size_t WS_DNK = WS_DNQ + al256((size_t)NCHUNK * 4 * 16384);
constexpr size_t WS_DNA = WS_DNK + al256((size_t)NCHUNK * 4 * 128 * 64 * 2);
constexpr size_t WS_DNGL = WS_DNA + al256((size_t)NCHUNK * 4 * 64 * 64 * 2);
constexpr size_t WS_DNO = WS_DNGL + al256((size_t)NCHUNK * 4 * 4);
constexpr size_t WS_LRA = WS_DNO + al256((size_t)M * 512 * 4);
constexpr size_t WS_LRH = WS_LRA + al256((size_t)M * 512 * 4);
constexpr size_t WS_LRC = WS_LRH + al256((size_t)M * 512 * 4);
constexpr size_t WS_VN = WS_LRC + al256((size_t)NPCH * 512 * 4);
constexpr size_t WS_PART = WS_VN + al256((size_t)M * 512 * 2);
constexpr size_t WS_STAT = WS_PART + al256((size_t)(FF / 512 > 4 ? FF / 512 : 4) * MS * D * 4);
constexpr size_t WS_END = WS_STAT + al256((size_t)M * 2 * 4); constexpr size_t WS_END_OLD_ = WS_PART + al256((size_t)(FF / 512 > 4 ? FF / 512 : 4) * MS * D * 4);
constexpr size_t O_YP = 0, O_YS = O_YP + (size_t)MP * D, O_RETP = O_YS + (size_t)MS * D, O_LHP = O_RETP + (size_t)DEPTH * BATCH * 4 * 16384,
    O_LCP = O_LHP + (size_t)DEPTH * BATCH * 512, O_DNP = O_LCP + (size_t)DEPTH * BATCH * 3 * 512, O_DCP = O_DNP + (size_t)DEPTH * BATCH * 4 * 16384,
    O_RETS = O_DCP + (size_t)DEPTH * BATCH * 3 * 1536, O_LHS = O_RETS + (size_t)DEPTH * DB * 4 * 16384, O_LCS = O_LHS + (size_t)DEPTH * DB * 512,
    O_DNS = O_LCS + (size_t)DEPTH * DB * 3 * 512, O_DCS = O_DNS + (size_t)DEPTH * DB * 4 * 16384, O_SGV = O_DCS + (size_t)DEPTH * DB * 3 * 1536,
    O_END = O_SGV + (size_t)DEPTH * DB * 32 * 512;
constexpr int CW_BAR = 4096;
constexpr int RING_BYTES = 131072, LDS_BYTES = 147456, MISC_OFF = LDS_BYTES - 1024;
constexpr int NWAVES = 8, NTHREADS = 512;
enum { I_XP = 0, I_XS, I_SRET, I_SLH, I_SLC, I_SDN, I_SDC, I_W1I, I_W1O, I_LN1G, I_LN1B, I_WMI, I_RETG, I_LCW, I_LCB, I_LWA, I_LBA, I_LWX, I_LBX, I_LAM,
       I_SGG, I_SGB, I_SGW, I_SGBS, I_DCW, I_DALOG, I_DDT, I_DNG, I_WMO, I_LN2G, I_LN2B, I_W2I, I_W2O, I_LN3G, I_LN3B, N_IN };
#ifdef HOST_EMU
static const float* const* g_emu_in = nullptr;
#define INP(k) (g_emu_in[k])
#else
DEV const float* in_ptr_(int k) {
    const __attribute__((address_space(4))) char* ka = (const __attribute__((address_space(4))) char*)__builtin_amdgcn_kernarg_segment_ptr();
    const unsigned long long v = *(volatile const __attribute__((address_space(4))) unsigned long long*)(ka + 8 * k);
    return (const float*)(const GAS float*)v;
}
#define INP(k) in_ptr_(k)
#endif

#define XB_TMO      128
#define XB_XCNT(j)  (256  + 64 * (j))
#define XB_XSUB(j)  (1280 + 64 * (j))
#define XB_XGEN(j)  (2304 + 64 * (j))
#define XB_TOP      3328
#define XB_TOPGEN   3392
#define XCD_BAR_WORDS 3456
#define XB_SPIN_CAP (1u << 18)
DEV unsigned xb_ld(unsigned* p)              { return __hip_atomic_load(p, __ATOMIC_RELAXED, __HIP_MEMORY_SCOPE_AGENT); }
DEV unsigned xb_add(unsigned* p, unsigned v) { return __hip_atomic_fetch_add(p, v, __ATOMIC_RELAXED, __HIP_MEMORY_SCOPE_AGENT); }
DEV unsigned xb_xcc_id() { return (unsigned)__builtin_amdgcn_s_getreg((3 << 11) | 20) & 0xFu; }
#define XB_SPIN(cond, bar) do { unsigned _sp = 0; while (cond) { __builtin_amdgcn_s_sleep(1); \
    if ((++_sp & 255u) == 0u) { if (xb_ld(&(bar)[XB_TMO])) break; if (_sp > XB_SPIN_CAP) { atomicAdd(&(bar)[XB_TMO], 1u); break; } } } } while (0)
struct XcdBarrier { unsigned* bar; unsigned x; volatile LAS unsigned* st; };
DEV XcdBarrier xcd_barrier_post(unsigned* bar, volatile LAS unsigned* st) {
    XcdBarrier b; b.bar = bar; b.x = xb_xcc_id(); b.st = st;
    if (threadIdx.x == 0) (void)xb_add(&bar[XB_XCNT(b.x)], 1u);
    return b;
}
DEV void xcd_barrier_complete(unsigned* bar, unsigned x, unsigned& nloc, unsigned& nx) {
    const unsigned G = gridDim.x * gridDim.y * gridDim.z;
    unsigned sum, cnt, mine, sp = 0u;
    for (;;) {
        sum = 0u; cnt = 0u; mine = 0u;
#pragma unroll
        for (unsigned j = 0; j < 16; ++j) { const unsigned c = xb_ld(&bar[XB_XCNT(j)]); sum += c; cnt += (c > 0u) ? 1u : 0u; mine = (j == x) ? c : mine; }
        if (sum == G) break;
        __builtin_amdgcn_s_sleep(1);
        if ((++sp & 255u) == 0u) { if (xb_ld(&bar[XB_TMO])) break; if (sp > XB_SPIN_CAP) { atomicAdd(&bar[XB_TMO], 1u); break; } }
    }
    nloc = mine > 0u ? mine : 1u; nx = cnt > 0u ? cnt : 1u;
}
DEV void xcd_barrier(const XcdBarrier& b) {
    WAIT_VM(0);
    __syncthreads();
    if (threadIdx.x == 0) {
        unsigned* bar = b.bar;
        __builtin_amdgcn_s_waitcnt(0);
        unsigned nloc = b.st[0], nx = b.st[1];
        if (nloc == 0u) { xcd_barrier_complete(bar, b.x, nloc, nx); b.st[0] = nloc; b.st[1] = nx; }
        const unsigned old = xb_add(&bar[XB_XSUB(b.x)], 1u);
        const unsigned gen = old / nloc;
        if (old + 1u == (gen + 1u) * nloc) {
            __builtin_amdgcn_fence(__ATOMIC_RELEASE, "agent");
            WAIT_VM(0);
            const unsigned og = xb_add(&bar[XB_TOP], 1u);
            const unsigned tg = og / nx;
            if (og + 1u == (tg + 1u) * nx) xb_add(&bar[XB_TOPGEN], 1u);
            else XB_SPIN(xb_ld(&bar[XB_TOPGEN]) == tg, bar);
            __builtin_amdgcn_fence(__ATOMIC_ACQUIRE, "agent");
            xb_add(&bar[XB_XGEN(b.x)], 1u);
            WAIT_VM(0);
        } else {
            XB_SPIN(xb_ld(&bar[XB_XGEN(b.x)]) == gen, bar);
            __builtin_amdgcn_fence(__ATOMIC_ACQUIRE, "agent");
            WAIT_VM(0);
        }
    }
    __syncthreads();
}

#ifdef HOST_EMU
#define WAVE_LDS_SYNC() emu::wave_sync()
#else
#define WAVE_LDS_SYNC() do { WAIT_LGKM(0); asm volatile("" ::: "memory"); } while (0)
#endif
#ifdef HOST_EMU
#define LDS_SYNC() emu::wg_barrier()
#else
#define LDS_SYNC() do { WAIT_LGKM(0); __builtin_amdgcn_s_barrier(); asm volatile("" ::: "memory"); } while (0)
#endif
DEV float wave_sum(float v) {
#pragma unroll
    for (int o = 1; o < 64; o <<= 1) v += SHFL_XOR(v, o);
    return v;
}
DEV bf16x8 lds_rowfrag(const LAS unsigned char* T, int ldb, int r0, int k0, int lane) { return *(const LAS bf16x8*)(T + (r0 + (lane & 15)) * ldb + (k0 + 8 * (lane >> 4)) * 2); }
DEV bf16x8 lds_trfrag(const LAS unsigned char* T, int ldb, int k0, int c0, int lane) {
    const int g = lane >> 4, q = (lane & 15) >> 2, p = lane & 3;
    const LAS unsigned char* a0 = T + (k0 + 8 * g + q) * ldb + (c0 + 4 * p) * 2;
    const s16x4 lo = DS_READ_TR16(a0), hi = DS_READ_TR16(a0 + 4 * ldb);
    return (bf16x8){lo[0], lo[1], lo[2], lo[3], hi[0], hi[1], hi[2], hi[3]};
}
DEV size_t frag_off(int r, int k, int nks) { return (size_t)(((r >> 4) * nks + (k >> 5)) * 1024 + ((k & 31) >> 3) * 256 + (r & 15) * 16 + (k & 7) * 2); }
DEV bf16x8 glb_frag(const bf16* base, int nks, int rt, int ks, int lane) { return *(const bf16x8*)((const char*)base + (size_t)(rt * nks + ks) * 1024 + lane * 16); }
DEV bf16x8 glb_rowfrag(const bf16* T, size_t ld, int r0, int k0, int lane) { return *(const bf16x8*)(T + (size_t)(r0 + (lane & 15)) * ld + k0 + 8 * (lane >> 4)); }
DEV void unpack8(const u32x4 v, float* f) { f[0] = bflo(v.x); f[1] = bfhi(v.x); f[2] = bflo(v.y); f[3] = bfhi(v.y); f[4] = bflo(v.z); f[5] = bfhi(v.z); f[6] = bflo(v.w); f[7] = bfhi(v.w); }
DEV u32x4 pack8(const float* f) { u32x4 o; o.x = pk2(f[0], f[1]); o.y = pk2(f[2], f[3]); o.z = pk2(f[4], f[5]); o.w = pk2(f[6], f[7]); return o; }

struct Ctx {
    LAS unsigned char* lds; int tid, lane, wave, wg, G, gw, NGW;
    float* out; unsigned char* ws;
};
struct Chunk { int row0, C, rot0, stream, n; bool sample; };
DEV Chunk chunk_of(int ck) {
    Chunk c;
    if (ck < NPCH) { c.sample = false; c.stream = ck / NCH; c.n = ck % NCH; c.row0 = ck * 64; c.C = 64; c.rot0 = c.n * 64; }
    else { c.sample = true; c.stream = ck - NPCH; c.n = 0; c.row0 = MP + 32 * c.stream; c.C = 32; c.rot0 = SEQ; }
    return c;
}

DEV void conv_item(const float* W, int ldw, int k0, int n0, int nvalid, bf16* WT, int K, int drow0, LAS float* scr, int lane) {
#pragma unroll
    for (int i = 0; i < 32; ++i) { const int kk = 2 * i + (lane >> 5), c = lane & 31; scr[kk * 33 + c] = (c < nvalid) ? NT_LOAD(&W[(size_t)(k0 + kk) * ldw + n0 + c]) : 0.f; }
    WAVE_LDS_SYNC();
    const int c = lane & 7;
#pragma unroll
    for (int j = 0; j < 4; ++j) { const int n = (lane >> 3) + 8 * j; const LAS float* s = scr + (8 * c) * 33 + n;
        u32x4 o; o.x = pk2(s[0 * 33], s[1 * 33]); o.y = pk2(s[2 * 33], s[3 * 33]); o.z = pk2(s[4 * 33], s[5 * 33]); o.w = pk2(s[6 * 33], s[7 * 33]);
        *(u32x4*)(WT + (size_t)(drow0 + n) * K + k0 + 8 * c) = o; }
    WAVE_LDS_SYNC();
}
DEV void conv_matrix(const Ctx& X, const float* W, int K, int ldw, int nblk, int lastvalid, bf16* WT, int mode, int gw, int ngw, int lo = 0, int hi = 1 << 30) {
    LAS float* scr = (LAS float*)(X.lds + X.wave * 16384);
    const int total = (K / 64) * nblk < hi ? (K / 64) * nblk : hi;
    for (int it = lo + gw; it < total; it += ngw) { const int kb = it / nblk, nb = it % nblk, n0 = nb * 32; int drow = n0;
        if (mode == 1) { const int up = n0 >= FF, nn = up ? n0 - FF : n0; drow = 256 * (nn / 128) + 128 * up + (nn % 128); }
        conv_item(W, ldw, kb * 64, n0, nb == nblk - 1 ? lastvalid : 32, WT, K, drow, scr, X.lane); }
}
DEV void convert_weights(const Ctx& X, int l, int mask, int gw, int ngw) {
    if (mask & 1) { conv_matrix(X, INP(I_W1I) + (size_t)l * D * 2 * FF, D, 2 * FF, 2 * FF / 32, 32, (bf16*)(X.ws + WS_W1I), 1, gw, ngw);
                    conv_matrix(X, INP(I_W1O) + (size_t)l * FF * D, FF, D, D / 32, 32, (bf16*)(X.ws + WS_W1O), 0, gw, ngw); }
    if (mask & 2) { bf16* WMI = (bf16*)(X.ws + WS_WMI); conv_matrix(X, INP(I_WMI) + (size_t)l * D * DIN, D, DIN, 193, 8, WMI, 0, gw, ngw);
        u32x4* z = (u32x4*)(WMI + (size_t)6176 * D); const size_t n16 = (size_t)(NPADW - 6176) * D * 2 / 16;
        for (size_t i = (size_t)gw * 64 + X.lane; i < n16; i += (size_t)ngw * 64) z[i] = (u32x4){0u, 0u, 0u, 0u}; }
    if (mask & 4) conv_matrix(X, INP(I_WMO) + (size_t)l * D * D, D, D, D / 32, 32, (bf16*)(X.ws + WS_WMO), 0, gw, ngw);
    if (mask & 8) { conv_matrix(X, INP(I_W2I) + (size_t)l * D * 2 * FF, D, 2 * FF, 2 * FF / 32, 32, (bf16*)(X.ws + WS_W2I), 1, gw, ngw);
                    conv_matrix(X, INP(I_W2O) + (size_t)l * FF * D, FF, D, D / 32, 32, (bf16*)(X.ws + WS_W2O), 0, gw, ngw); }
}
enum { T_W1I = 0, T_W1O, T_WMI, T_WMO, T_W2I, T_W2O };
constexpr int CV_ALL = 1 << 30;
DEV void conv_task(const Ctx& X, int l, int task, int lo, int hi, int gw, int ngw) {
    if (task == T_W1I) conv_matrix(X, INP(I_W1I) + (size_t)l * D * 2 * FF, D, 2 * FF, 2 * FF / 32, 32, (bf16*)(X.ws + WS_W1I), 1, gw, ngw, lo, hi);
    else if (task == T_W1O) conv_matrix(X, INP(I_W1O) + (size_t)l * FF * D, FF, D, D / 32, 32, (bf16*)(X.ws + WS_W1O), 0, gw, ngw, lo, hi);
    else if (task == T_WMI) { bf16* WMI = (bf16*)(X.ws + WS_WMI); conv_matrix(X, INP(I_WMI) + (size_t)l * D * DIN, D, DIN, 193, 8, WMI, 0, gw, ngw, lo, hi);
        if (hi >= (D / 64) * 193) { u32x4* z = (u32x4*)(WMI + (size_t)6176 * D); const size_t n16 = (size_t)(NPADW - 6176) * D * 2 / 16;
            for (size_t i = (size_t)gw * 64 + X.lane; i < n16; i += (size_t)ngw * 64) z[i] = (u32x4){0u, 0u, 0u, 0u}; } }
    else if (task == T_WMO) conv_matrix(X, INP(I_WMO) + (size_t)l * D * D, D, D, D / 32, 32, (bf16*)(X.ws + WS_WMO), 0, gw, ngw, lo, hi);
    else if (task == T_W2I) conv_matrix(X, INP(I_W2I) + (size_t)l * D * 2 * FF, D, 2 * FF, 2 * FF / 32, 32, (bf16*)(X.ws + WS_W2I), 1, gw, ngw, lo, hi);
    else conv_matrix(X, INP(I_W2O) + (size_t)l * FF * D, FF, D, D / 32, 32, (bf16*)(X.ws + WS_W2O), 0, gw, ngw, lo, hi);
}
#define TAIL_BEGIN(nunits) { const int tf_ = ((nunits) % X.G) ? ((nunits) % X.G) : 0; if (X.wg >= tf_) { const int tgw_ = (X.wg - tf_) * NWAVES + X.wave, tng_ = (X.G - tf_) * NWAVES;
#define TAIL_CONV(l_, task, lo, hi) conv_task(X, (l_), (task), (lo), (hi), tgw_, tng_);
#define TAIL_END } }
DEV void prologue_misc(const Ctx& X) {
    const size_t gt = (size_t)X.wg * NTHREADS + X.tid, GT = (size_t)X.G * NTHREADS;
    { float* rot = (float*)(X.ws + WS_ROT);
      for (size_t i = gt; i < (size_t)(SEQ + 32) * 64; i += GT) { const int p = (int)(i / 64), k = (int)(i % 64); const float pos = (float)(p < SEQ ? p : PAST + (p - SEQ));
          const float inv = powf(10000.f, -(float)k / 64.f); const float ang = pos * inv; rot[2 * i] = cosf(ang); rot[2 * i + 1] = sinf(ang); } }
    { bf16* dst = (bf16*)(X.ws + WS_LRUW);
      for (size_t i = gt; i < (size_t)DEPTH * 2 * 8 * 4096; i += GT) { const int ii = (int)(i % 64), j = (int)((i / 64) % 64), h = (int)((i / 4096) % 8), m = (int)((i / 32768) % 2), l = (int)(i / 65536);
          *(bf16*)((unsigned char*)dst + (size_t)((l * 2 + m) * 8 + h) * 8192 + frag_off(j, ii, 2)) = (bf16)f2bf((m ? INP(I_LWX) : INP(I_LWA))[(((size_t)l * 8 + h) * 64 + ii) * 64 + j]); } }
    { bf16* dst = (bf16*)(X.ws + WS_SGW);
      for (size_t i = gt; i < (size_t)DEPTH * 4 * 16384; i += GT) { const int j = (int)(i % 128), ii = (int)((i / 128) % 128); *(bf16*)((unsigned char*)dst + (i / 16384) * 32768 + frag_off(ii, j, 4)) = ((j >> 6) <= (ii >> 6)) ? (bf16)f2bf(INP(I_SGW)[i]) : (bf16)0; } }
    { bf16* xb = (bf16*)(X.ws + WS_XB);
      for (int row = X.gw; row < M; row += X.NGW) { const float* src = row < MP ? INP(I_XP) + (size_t)row * D : INP(I_XS) + (size_t)(row - MP) * D;
#pragma unroll
          for (int j = 0; j < 8; ++j) { const f32x4 v = *(const f32x4*)(src + 4 * (X.lane + 64 * j)); u32x2 o; o.x = pk2(v.x, v.y); o.y = pk2(v.z, v.w); *(u32x2*)(xb + (size_t)row * D + 4 * (X.lane + 64 * j)) = o; } } }
}

DEV void ln_row_finish(const Ctx& X, f32x4 (&v)[8], int row, const f32x4 (&gg)[8], const f32x4 (&bb)[8], float* xf, bool write_xb) {
    bf16* xb = (bf16*)(X.ws + WS_XB); float s = 0.f;
#pragma unroll
    for (int j = 0; j < 8; ++j) s += (v[j].x + v[j].y) + (v[j].z + v[j].w);
    const float mean = wave_sum(s) * (1.f / D); float s2 = 0.f;
#pragma unroll
    for (int j = 0; j < 8; ++j) { v[j] = v[j] - mean; s2 += (v[j].x * v[j].x + v[j].y * v[j].y) + (v[j].z * v[j].z + v[j].w * v[j].w); }
    const float rstd = 1.f / sqrtf(wave_sum(s2) * (1.f / D) + LN_EPS);
    if (X.lane == 0) *(f32x2*)((float*)(X.ws + WS_STAT) + (size_t)row * 2) = (f32x2){mean, rstd};
#pragma unroll
    for (int j = 0; j < 8; ++j) { const int c = 4 * (X.lane + 64 * j);
        const f32x4 o = v[j] * rstd * gg[j] + bb[j]; if (xf) *(f32x4*)(xf + (size_t)row * D + c) = o;
        if (write_xb) { u32x2 p; p.x = pk2(o.x, o.y); p.y = pk2(o.z, o.w); *(u32x2*)(xb + (size_t)row * D + c) = p; } }
}
DEV void ln_phase(const Ctx& X, const float* Zc_, const float* g, const float* b, float* xf, bool write_xb, const float* xs_raw, const float* Zp, const float* gp, const float* bp, float scale, int nparts) {
    const float* PART = (const float*)(X.ws + WS_PART); float* Zc = (float*)Zc_; const float* STAT = (const float*)(X.ws + WS_STAT);
    f32x4 gg[8], bb[8];
#pragma unroll
    for (int j = 0; j < 8; ++j) { gg[j] = *(const f32x4*)(g + 4 * (X.lane + 64 * j)); bb[j] = *(const f32x4*)(b + 4 * (X.lane + 64 * j)); }
    { f32x4 v[8], nx[8]; int row = X.gw;
      if (row < MP) { const f32x4* zr = (const f32x4*)(Zc + (size_t)row * D) + X.lane;
#pragma unroll
          for (int j = 0; j < 8; ++j) v[j] = zr[64 * j]; }
      while (row < MP) {
          const int nrow = row + X.NGW;
          if (nrow < MP) { const f32x4* zr = (const f32x4*)(Zc + (size_t)nrow * D) + X.lane;
#pragma unroll
              for (int j = 0; j < 8; ++j) nx[j] = zr[64 * j]; }
          ln_row_finish(X, v, row, gg, bb, xf, write_xb);
#pragma unroll
          for (int j = 0; j < 8; ++j) v[j] = nx[j];
          row = nrow; } }
    for (int r = X.gw; r < MS; r += X.NGW) { f32x4 v[8]; const int row = MP + r;
#pragma unroll
        for (int j = 0; j < 8; ++j) v[j] = ((const f32x4*)(PART + (size_t)r * D) + X.lane)[64 * j];
#pragma unroll 1
        for (int p = 1; p < nparts; ++p) {
#pragma unroll
            for (int j = 0; j < 8; ++j) v[j] += ((const f32x4*)(PART + ((size_t)p * MS + r) * D) + X.lane)[64 * j]; }
        if (xs_raw) {
#pragma unroll
            for (int j = 0; j < 8; ++j) v[j] = ((const f32x4*)(xs_raw + (size_t)r * D) + X.lane)[64 * j] * ALPHA + v[j] * scale; }
        else { const f32x2 st = *(const f32x2*)(STAT + (size_t)row * 2);
#pragma unroll
            for (int j = 0; j < 8; ++j) { const int c = 4 * (X.lane + 64 * j); const f32x4 x = (((const f32x4*)(Zp + (size_t)row * D) + X.lane)[64 * j] - st.x) * st.y * *(const f32x4*)(gp + c) + *(const f32x4*)(bp + c);
                v[j] = x * ALPHA + v[j] * scale; } }
#pragma unroll
        for (int j = 0; j < 8; ++j) ((f32x4*)(Zc + (size_t)row * D) + X.lane)[64 * j] = v[j];
        ln_row_finish(X, v, row, gg, bb, xf, write_xb); }
}

struct EpiSwiglu {
    static constexpr bool PERM = true, AFTER_DRAIN = false; bf16* H;
    DEV void operator()(const f32x4 (&acc)[2][2][4][2], const pg8::Unit& u, int wr, int wc, int fr, int fq) const {
#pragma unroll
        for (int ai = 0; ai < 2; ++ai)
#pragma unroll
            for (int m = 0; m < 4; ++m) { const int row = u.pm * 256 + ai * 128 + wr * 64 + m * 16 + fr; float o[8];
#pragma unroll
                for (int n = 0; n < 2; ++n)
#pragma unroll
                    for (int j = 0; j < 4; ++j) { const float gt = acc[ai][0][m][n][j], up = acc[ai][1][m][n][j]; o[4 * n + j] = siluf_(gt) * up; }
                *(u32x4*)(H + (size_t)row * FF + u.pn * 128 + wc * 32 + fq * 8) = pack8(o); }
    }
};
struct EpiResid {
    static constexpr bool PERM = true, AFTER_DRAIN = false; const float* xp; const float* zprev; const float* stat; const float* g; const float* b; float* Z; float scale;
    DEV void operator()(const f32x4 (&acc)[2][2][4][2], const pg8::Unit& u, int wr, int wc, int fr, int fq) const {
#pragma unroll
        for (int ai = 0; ai < 2; ++ai)
#pragma unroll
            for (int m = 0; m < 4; ++m) { const int row = u.pm * 256 + ai * 128 + wr * 64 + m * 16 + fr;
                const float* xr = (xp ? xp : zprev) + (size_t)row * D; f32x2 st = (f32x2){0.f, 1.f}; if (!xp) st = *(const f32x2*)(stat + (size_t)row * 2);
#pragma unroll
                for (int bj = 0; bj < 2; ++bj) { const int col = u.pn * 256 + bj * 128 + wc * 32 + fq * 8;
#pragma unroll
                    for (int n = 0; n < 2; ++n) { f32x4 xv = *(const f32x4*)(xr + col + 4 * n);
                        if (!xp) xv = (xv - st.x) * st.y * *(const f32x4*)(g + col + 4 * n) + *(const f32x4*)(b + col + 4 * n);
                        *(f32x4*)(Z + (size_t)row * D + col + 4 * n) = xv * ALPHA + acc[ai][bj][m][n] * scale; } } }
    }
};
constexpr int KS_FF = (FF % 512 == 0) ? 512 : FF, KS_D = 512;
struct EpiPart {
    static constexpr bool PERM = true, AFTER_DRAIN = false; float* part; int klen;
    DEV void operator()(const f32x4 (&acc)[2][2][4][2], const pg8::Unit& u, int wr, int wc, int fr, int fq) const {
        float* base = part + (size_t)(u.k0 / klen) * MS * D;
#pragma unroll
        for (int ai = 0; ai < 2; ++ai)
#pragma unroll
            for (int m = 0; m < 4; ++m) { const int row = u.pm * 256 + ai * 128 + wr * 64 + m * 16 + fr - MP;
#pragma unroll
                for (int bj = 0; bj < 2; ++bj) { const int col = u.pn * 256 + bj * 128 + wc * 32 + fq * 8;
#pragma unroll
                    for (int n = 0; n < 2; ++n) *(f32x4*)(base + (size_t)row * D + col + 4 * n) = acc[ai][bj][m][n]; } }
    }
};
struct EpiProj {
    static constexpr bool PERM = true, AFTER_DRAIN = false; bf16* P; float* gab;
    DEV void operator()(const f32x4 (&acc)[2][2][4][2], const pg8::Unit& u, int wr, int wc, int fr, int fq) const {
#pragma unroll
        for (int ai = 0; ai < 2; ++ai)
#pragma unroll
            for (int m = 0; m < 4; ++m) { const int row = u.pm * 256 + ai * 128 + wr * 64 + m * 16 + fr;
                if (u.pn < NPROJ / 256) {
#pragma unroll
                    for (int bj = 0; bj < 2; ++bj) { float o[8];
#pragma unroll
                        for (int n = 0; n < 2; ++n)
#pragma unroll
                            for (int j = 0; j < 4; ++j) o[4 * n + j] = acc[ai][bj][m][n][j];
                        *(u32x4*)(P + (size_t)row * NPROJ + u.pn * 256 + bj * 128 + wc * 32 + fq * 8) = pack8(o); }
                } else if (wc == 0 && fq == 0) { *(f32x4*)(gab + (size_t)row * 8) = acc[ai][0][m][0]; *(f32x4*)(gab + (size_t)row * 8 + 4) = acc[ai][0][m][1]; } }
    }
};

constexpr int LD136 = 272, LD72 = 144;
DEV float ret_log_g(int h) { return log1pf(-exp2f(-5.f - (float)h)); }
DEV void rot_piece(const bf16* src_row_head, const float* rotrow, int d, float scale, LAS unsigned char* T, int j) {
    float x1[8], x2[8], o1[8], o2[8]; unpack8(*(const u32x4*)(src_row_head + d), x1); unpack8(*(const u32x4*)(src_row_head + 64 + d), x2);
#pragma unroll
    for (int i = 0; i < 8; ++i) { const f32x2 cs = *(const f32x2*)(rotrow + 2 * (d + i)); o1[i] = (x1[i] * cs.x - x2[i] * cs.y) * scale; o2[i] = (x1[i] * cs.y + x2[i] * cs.x) * scale; }
    *(LAS u32x4*)(T + j * LD136 + d * 2) = pack8(o1); *(LAS u32x4*)(T + j * LD136 + (64 + d) * 2) = pack8(o2);
}
DEV void ret_u_unit(const Ctx& X, int ck, int h) {
    const Chunk c = chunk_of(ck); const bf16* P = (const bf16*)(X.ws + WS_HP); const float* rot = (const float*)(X.ws + WS_ROT);
    LAS unsigned char* Kd = X.lds; LAS unsigned char* Vs = X.lds + 17408; const float lg = ret_log_g(h);
    for (int idx = X.tid; idx < c.C * 8; idx += NTHREADS) { const int j = idx >> 3, d = (idx & 7) * 8;
        rot_piece(P + (size_t)(c.row0 + j) * NPROJ + 512 + h * 128, rot + (size_t)(c.rot0 + j) * 128, d, 0.08838834764831845f * __expf(lg * (float)(c.C - 1 - j)), Kd, j); }
    for (int idx = X.tid; idx < c.C * 16; idx += NTHREADS) { const int j = idx >> 4, o = (idx & 15) * 8;
        *(LAS u32x4*)(Vs + j * LD136 + o * 2) = *(const u32x4*)(P + (size_t)(c.row0 + j) * NPROJ + 1024 + h * 128 + o); }
    LDS_SYNC();
    f32x4 acc[8];
#pragma unroll
    for (int t = 0; t < 8; ++t) acc[t] = (f32x4){0.f, 0.f, 0.f, 0.f};
    for (int ks = 0; ks < c.C / 32; ++ks) { const bf16x8 a = lds_trfrag(Kd, LD136, 32 * ks, 16 * X.wave, X.lane);
#pragma unroll
        for (int t = 0; t < 8; ++t) acc[t] = mfma16(a, lds_trfrag(Vs, LD136, 32 * ks, 16 * t, X.lane), acc[t]); }
    float* U = (float*)(X.ws + WS_U) + (size_t)(ck * 4 + h) * 16384;
#pragma unroll
    for (int t = 0; t < 8; ++t)
#pragma unroll
        for (int r = 0; r < 4; ++r) U[(16 * X.wave + 4 * (X.lane >> 4) + r) * 128 + 16 * t + (X.lane & 15)] = acc[t][r];
    LDS_SYNC();
}
DEV void conv16(const Ctx& X, const Chunk& c, int l, int t, int pcol, const float* state, int swidth, int scol, const float* cw, int cws, float (&y)[16]) {
    const bf16* P = (const bf16*)(X.ws + WS_HP);
#pragma unroll
    for (int i = 0; i < 16; ++i) y[i] = 0.f;
#pragma unroll
    for (int j = 0; j < 4; ++j) { const int tt = t - 3 + j; float xr[16];
        if (tt >= 0 || (!c.sample && c.n > 0)) { const bf16* src = P + (size_t)(c.row0 + tt) * NPROJ + pcol; unpack8(*(const u32x4*)src, xr); unpack8(*(const u32x4*)(src + 8), xr + 8); }
        else if (c.sample) { const f32x4* s = (const f32x4*)(state + ((size_t)(l * DB + c.stream) * 3 + (3 + tt)) * swidth + scol);
#pragma unroll
            for (int i = 0; i < 4; ++i) { const f32x4 v = s[i]; xr[4 * i] = v.x; xr[4 * i + 1] = v.y; xr[4 * i + 2] = v.z; xr[4 * i + 3] = v.w; } }
        else {
#pragma unroll
            for (int i = 0; i < 16; ++i) xr[i] = 0.f; }
        const f32x4* w4 = (const f32x4*)(cw + (size_t)j * cws);
#pragma unroll
        for (int i = 0; i < 4; ++i) { const f32x4 w = w4[i]; y[4 * i] += w.x * xr[4 * i]; y[4 * i + 1] += w.y * xr[4 * i + 1]; y[4 * i + 2] += w.z * xr[4 * i + 2]; y[4 * i + 3] += w.w * xr[4 * i + 3]; } }
}
DEV void dn_prep_unit(const Ctx& X, int l, int ck, int h) {
    const Chunk c = chunk_of(ck); const int unit = ck * 4 + h; const float* gab = (const float*)(X.ws + WS_GAB);
    LAS float* RHS = (LAS float*)X.lds; LAS unsigned char* Qs = X.lds + 66560; LAS unsigned char* Ks = X.lds + 83968; LAS unsigned char* XT = X.lds + 66560;
    LAS unsigned char* Aoff = X.lds + 103424; LAS float* Adiag = (LAS float*)(X.lds + 112640); LAS unsigned char* DI = X.lds + 116736; LAS unsigned char* TT = X.lds + 121856;
    LAS float* sG = (LAS float*)(X.lds + 142336); LAS float* sB = sG + 64; LAS float* sGC = sG + 128;
    if (X.tid < c.C) { const int row = c.row0 + X.tid;
        sG[X.tid] = -__expf(INP(I_DALOG)[l * 4 + h]) * softplusf_(gab[(size_t)row * 8 + h] + INP(I_DDT)[l * 4 + h]); sB[X.tid] = sigmoidf_(gab[(size_t)row * 8 + 4 + h]); }
    LDS_SYNC();
    if (X.wave == 0) { float sc = X.lane < c.C ? sG[X.lane] : 0.f;
#pragma unroll
        for (int d = 1; d < 64; d <<= 1) { const float o = SHFL_UP(sc, d); if (X.lane >= d) sc += o; }
        if (X.lane < c.C) sGC[X.lane] = sc; }
    LDS_SYNC();
    { const int t0 = X.tid >> 3, part = X.tid & 7, t = t0 < c.C ? t0 : c.C - 1; const bool valid = t0 < c.C; const int row = c.row0 + t;
      const float beta = sB[t], gc = sGC[t], gl = sGC[c.C - 1], egc = __expf(gc), ekd = __expf(gl - gc);
      const float* cw = INP(I_DCW) + (size_t)l * 4 * 1536;
#pragma unroll
      for (int mm = 0; mm < 3; ++mm) {
          const int cc = mm * 512 + h * 128 + 16 * part; float y[16];
          conv16(X, c, l, t, 4096 + cc, INP(I_SDC), 1536, cc, cw + cc, 1536, y);
#pragma unroll
          for (int i = 0; i < 16; ++i) y[i] = siluf_(y[i]);
          if (mm < 2) { float ss = 0.f;
#pragma unroll
              for (int i = 0; i < 16; ++i) ss += y[i] * y[i];
              ss += SHFL_XOR(ss, 1); ss += SHFL_XOR(ss, 2); ss += SHFL_XOR(ss, 4);
              const float rn = (mm == 0 ? 0.08838834764831845f : 1.f) / sqrtf(ss + 1e-6f);
#pragma unroll
              for (int i = 0; i < 16; ++i) y[i] *= rn; }
          if (valid) {
              if (mm == 0) { float qd[16];
#pragma unroll
                  for (int i = 0; i < 16; ++i) qd[i] = y[i] * egc;
                  *(LAS u32x4*)(Qs + t * LD136 + part * 32) = pack8(y); *(LAS u32x4*)(Qs + t * LD136 + part * 32 + 16) = pack8(y + 8);
                  unsigned char* dq = X.ws + WS_DNQ + (size_t)unit * 16384; *(u32x4*)(dq + frag_off(t, 16 * part, 4)) = pack8(qd); *(u32x4*)(dq + frag_off(t, 16 * part + 8, 4)) = pack8(qd + 8); }
              else if (mm == 1) {
                  *(LAS u32x4*)(Ks + t * LD136 + part * 32) = pack8(y); *(LAS u32x4*)(Ks + t * LD136 + part * 32 + 16) = pack8(y + 8);
                  unsigned char* dk = X.ws + WS_DNK + (size_t)unit * 16384 + frag_off(16 * part, t, 2);
#pragma unroll
                  for (int i = 0; i < 16; ++i) { *(bf16*)(dk + i * 16) = (bf16)f2bf(y[i] * ekd); RHS[t * 260 + 128 + 16 * part + i] = beta * egc * y[i]; } }
              else {
#pragma unroll
                  for (int i = 0; i < 16; ++i) RHS[t * 260 + 16 * part + i] = beta * y[i]; } } }
      if (X.tid == 0) ((float*)(X.ws + WS_DNGL))[unit] = gl; }
    LDS_SYNC();
    { const int nt = c.C / 16; unsigned char* attn = X.ws + WS_DNA + (size_t)unit * 8192;
      for (int tt = X.wave; tt < 2 * nt * nt; tt += NWAVES) { const int which = tt / (nt * nt), it = (tt % (nt * nt)) / nt, jt = tt % nt;
          f32x4 acc = (f32x4){0.f, 0.f, 0.f, 0.f};
          if (jt <= it) {
#pragma unroll
              for (int ks = 0; ks < 4; ++ks) acc = mfma16(lds_rowfrag(which ? Qs : Ks, LD136, 16 * it, 32 * ks, X.lane), lds_rowfrag(Ks, LD136, 16 * jt, 32 * ks, X.lane), acc); }
          const int j = 16 * jt + (X.lane & 15); const float gcj = sGC[j];
#pragma unroll
          for (int r = 0; r < 4; ++r) { const int i = 16 * it + 4 * (X.lane >> 4) + r; const float dec = __expf(fminf(sGC[i] - gcj, 0.f));
              if (which == 0) { const float a = (j < i) ? sB[i] * acc[r] * dec : 0.f;
                  if (it == jt) Adiag[(it * 16 + (i & 15)) * 16 + (j & 15)] = a;
                  *(LAS bf16*)(Aoff + i * LD72 + j * 2) = (bf16)((it == jt) ? 0u : f2bf(a)); }
              else *(bf16*)(attn + frag_off(i, j, 2)) = (bf16)((j <= i) ? f2bf(acc[r] * dec) : 0u); } } }
    LDS_SYNC();
    { const int nb = c.C / 16, lane = X.lane, g = lane >> 4, lc = lane & 15, w = X.wave;
      for (int i = X.tid; i < 36864 / 16; i += NTHREADS) *(LAS u32x4*)(XT + i * 16) = (u32x4){0u, 0u, 0u, 0u};
      for (int i = X.tid; i < 20480 / 16; i += NTHREADS) *(LAS u32x4*)(TT + i * 16) = (u32x4){0u, 0u, 0u, 0u};
      if (w == 0 && g < nb) { float x[16];
#pragma unroll
          for (int i = 0; i < 16; ++i) { float a = (i == lc) ? 1.f : 0.f;
#pragma unroll
              for (int j = 0; j < i; ++j) a -= Adiag[(g * 16 + i) * 16 + j] * x[j];
              x[i] = a; }
#pragma unroll
          for (int i = 0; i < 16; ++i) *(LAS bf16*)(DI + (g * 16 + i) * 80 + lc * 2) = (bf16)f2bf(x[i]);
          *(LAS u32x4*)(DI + (g * 16 + lc) * 80 + 32) = (u32x4){0u, 0u, 0u, 0u}; *(LAS u32x4*)(DI + (g * 16 + lc) * 80 + 48) = (u32x4){0u, 0u, 0u, 0u}; }
      LDS_SYNC();
      LAS unsigned char* TTw = TT + w * 2560;
      for (int b = 0; b < nb; ++b) { const int nks = (16 * b + 31) / 32;
#pragma unroll
          for (int tt = 0; tt < 2; ++tt) { const int ct = w + 8 * tt; f32x4 acc = (f32x4){0.f, 0.f, 0.f, 0.f};
              for (int ks = 0; ks < nks; ++ks) acc = mfma16(lds_rowfrag(Aoff, LD72, 16 * b, 32 * ks, lane), lds_rowfrag(XT, LD72, 16 * ct, 32 * ks, lane), acc);
              float t4[4];
#pragma unroll
              for (int r = 0; r < 4; ++r) t4[r] = RHS[(16 * b + 4 * g + r) * 260 + 16 * ct + lc] - acc[r];
              u32x2 p; p.x = pk2(t4[0], t4[1]); p.y = pk2(t4[2], t4[3]); *(LAS u32x2*)(TTw + (16 * tt + lc) * 80 + 8 * g) = p; }
          WAVE_LDS_SYNC();
#pragma unroll
          for (int tt = 0; tt < 2; ++tt) { const int ct = w + 8 * tt, cc = 16 * ct + lc;
              const f32x4 xv = mfma16(lds_rowfrag(DI + b * 1280, 80, 0, 0, lane), lds_rowfrag(TTw, 80, 16 * tt, 0, lane), (f32x4){0.f, 0.f, 0.f, 0.f});
              u32x2 p; p.x = pk2(xv[0], xv[1]); p.y = pk2(xv[2], xv[3]); *(LAS u32x2*)(XT + cc * LD72 + (16 * b + 4 * g) * 2) = p;
              if (cc < 128) { bf16* dst = (bf16*)(X.ws + WS_DNU) + (size_t)(c.row0 + 16 * b + 4 * g) * 512 + h * 128 + cc;
#pragma unroll
                  for (int r = 0; r < 4; ++r) dst[(size_t)r * 512] = (bf16)f2bf(xv[r]); }
              else { unsigned char* dst = X.ws + WS_DNW + (size_t)unit * 16384 + frag_off(16 * b + 4 * g, cc - 128, 4);
#pragma unroll
                  for (int r = 0; r < 4; ++r) *(bf16*)(dst + r * 16) = (bf16)f2bf(xv[r]); } }
          WAVE_LDS_SYNC(); } }
    LDS_SYNC();
}
DEV void lru_prep_unit(const Ctx& X, int l, int ck, int q4) {
    const Chunk c = chunk_of(ck); const int c0 = q4 * 128;
    LAS float* XC = (LAS float*)X.lds; LAS unsigned char* XCb = X.lds + 33792; LAS float* AA = (LAS float*)(X.lds + 51200);
    { const int t0 = X.tid >> 3, part = X.tid & 7; if (t0 < c.C) { const int t = t0, cc = c0 + 16 * part; float y[16]; conv16(X, c, l, t, 2560 + cc, INP(I_SLC), 512, cc, INP(I_LCW) + (size_t)l * 4 * 512 + cc, 512, y);
          const float* cb = INP(I_LCB) + (size_t)l * 512;
#pragma unroll
          for (int i = 0; i < 16; ++i) { y[i] += cb[cc + i]; XC[t * 132 + 16 * part + i] = y[i]; }
          *(LAS u32x4*)(XCb + t * LD136 + part * 32) = pack8(y); *(LAS u32x4*)(XCb + t * LD136 + part * 32 + 16) = pack8(y + 8); } }
    LDS_SYNC();
    { const bf16* WT = (const bf16*)(X.ws + WS_LRUW) + (size_t)l * 2 * 8 * 4096; const int ct = X.wave, hb = 2 * q4 + (ct >> 2), j0 = 16 * (ct & 3);
      const int cl = 16 * ct + (X.lane & 15), cg = c0 + cl;
      const float ba = INP(I_LBA)[l * 512 + cg], bx = INP(I_LBX)[l * 512 + cg], spl = softplusf_(-INP(I_LAM)[l * 512 + cg]);
      for (int rt = 0; rt < c.C / 16; ++rt) { f32x4 aR = (f32x4){0.f, 0.f, 0.f, 0.f}, aI = aR;
#pragma unroll
          for (int ks = 0; ks < 2; ++ks) { const bf16x8 a = lds_rowfrag(XCb, LD136, 16 * rt, (ct >> 2) * 64 + 32 * ks, X.lane);
              aR = mfma16(a, glb_frag(WT + (size_t)hb * 4096, 2, j0 >> 4, ks, X.lane), aR); aI = mfma16(a, glb_frag(WT + (size_t)(8 + hb) * 4096, 2, j0 >> 4, ks, X.lane), aI); }
#pragma unroll
          for (int r = 0; r < 4; ++r) { const int t = 16 * rt + 4 * (X.lane >> 4) + r; const float rr = sigmoidf_(aR[r] + ba), ii = sigmoidf_(aI[r] + bx);
              const float la = -8.f * rr * spl, a = __expf(la), bb = sqrtf(-expm1f(2.f * la)) * (ii * XC[t * 132 + cl]); AA[t * 132 + cl] = a; XC[t * 132 + cl] = bb; } } }
    LDS_SYNC();
    if (X.tid < 128) { const int cl = X.tid; float hl = 0.f, ac = 1.f; float* LRH = (float*)(X.ws + WS_LRH); float* LRA = (float*)(X.ws + WS_LRA);
        for (int t0 = 0; t0 < c.C; t0 += 8) { float a8[8], b8[8];
#pragma unroll
            for (int k = 0; k < 8; ++k) { a8[k] = AA[(t0 + k) * 132 + cl]; b8[k] = XC[(t0 + k) * 132 + cl]; }
#pragma unroll
            for (int k = 0; k < 8; ++k) { hl = a8[k] * hl + b8[k]; ac *= a8[k]; LRH[(size_t)(c.row0 + t0 + k) * 512 + c0 + cl] = hl; LRA[(size_t)(c.row0 + t0 + k) * 512 + c0 + cl] = ac; } } }
    else if (X.tid < 512 && (c.sample || c.n == NCH - 1)) {
        const int e = X.tid - 128, tt = e >> 7, cl = e & 127; const bf16* P = (const bf16*)(X.ws + WS_HP);
        const float v = bf2f(P[(size_t)(c.row0 + c.C - 3 + tt) * NPROJ + 2560 + c0 + cl]);
        float* o = X.out + (c.sample ? O_LCS + ((size_t)(l * DB + c.stream) * 3 + tt) * 512 : O_LCP + ((size_t)(l * BATCH + c.stream) * 3 + tt) * 512) + c0 + cl; *o = v; }
    LDS_SYNC();
}
DEV void sg_ln_rows(const Ctx& X, int l) {
    const bf16* P = (const bf16*)(X.ws + WS_HP); bf16* VN = (bf16*)(X.ws + WS_VN); const float* g = INP(I_SGG) + l * 512; const float* b = INP(I_SGB) + l * 512;
    for (int row = X.gw; row < M; row += X.NGW) { float v[8]; unpack8(*(const u32x4*)(P + (size_t)row * NPROJ + 3584 + 8 * X.lane), v); float s = 0.f;
#pragma unroll
        for (int i = 0; i < 8; ++i) { v[i] = geluf_(v[i]); s += v[i]; }
        const float mean = wave_sum(s) * (1.f / 512.f); float s2 = 0.f;
#pragma unroll
        for (int i = 0; i < 8; ++i) { v[i] -= mean; s2 += v[i] * v[i]; }
        const float rstd = 1.f / sqrtf(wave_sum(s2) * (1.f / 512.f) + LN_EPS);
#pragma unroll
        for (int i = 0; i < 8; ++i) v[i] = v[i] * rstd * g[8 * X.lane + i] + b[8 * X.lane + i];
        *(u32x4*)(VN + (size_t)row * 512 + 8 * X.lane) = pack8(v);
        if (row >= MP) { float* o = X.out + O_SGV + ((size_t)l * MS + (row - MP)) * 512 + 8 * X.lane; *(f32x4*)o = (f32x4){v[0], v[1], v[2], v[3]}; *(f32x4*)(o + 4) = (f32x4){v[4], v[5], v[6], v[7]}; } }
}

DEV void dn_seq_unit(const Ctx& X, int l, bool sample, int stream, int h, int s4) {
    LAS unsigned char* ST = X.lds; LAS unsigned char* VT = X.lds + 8704;
    const int w = X.wave, lane = X.lane, g = lane >> 4, lc = lane & 15, it = w & 3, et = w >> 2;
    const int C = sample ? 32 : 64, nsteps = sample ? 1 : NCH; const bool v12 = it < C / 16;
    f32x4 S[2];
    if (sample) { const float* s0 = INP(I_SDN) + ((size_t)(l * DB + stream) * 4 + h) * 16384;
#pragma unroll
        for (int t = 0; t < 2; ++t)
#pragma unroll
            for (int r = 0; r < 4; ++r) S[t][r] = s0[(16 * w + 4 * g + r) * 128 + 32 * s4 + 16 * t + lc]; }
    else { S[0] = (f32x4){0.f, 0.f, 0.f, 0.f}; S[1] = S[0]; }
    const bf16* DNU = (const bf16*)(X.ws + WS_DNU); const bf16* DNW = (const bf16*)(X.ws + WS_DNW); const bf16* DNQ = (const bf16*)(X.ws + WS_DNQ);
    const bf16* DNK = (const bf16*)(X.ws + WS_DNK); const bf16* DNA = (const bf16*)(X.ws + WS_DNA); const float* DNGL = (const float*)(X.ws + WS_DNGL); float* DNO = (float*)(X.ws + WS_DNO);
    struct Ops { bf16x8 wf[4], qf[4], af[2], kf[2]; unsigned uu[4]; float gl; };
    const int ri = v12 ? 16 * it : 0;
#define DN_LOAD(O, n_) do { const int ck_ = sample ? NPCH + stream : stream * NCH + (n_), unit_ = ck_ * 4 + h, row0_ = sample ? MP + 32 * stream : ck_ * 64; \
        _Pragma("unroll") for (int ks = 0; ks < 4; ++ks) { (O).wf[ks] = glb_frag(DNW + (size_t)unit_ * 8192, 4, ri >> 4, ks, lane); (O).qf[ks] = glb_frag(DNQ + (size_t)unit_ * 8192, 4, ri >> 4, ks, lane); } \
        _Pragma("unroll") for (int ks = 0; ks < 2; ++ks) { const int kk = (ks < C / 32) ? ks : 0; (O).af[ks] = glb_frag(DNA + (size_t)unit_ * 4096, 2, ri >> 4, kk, lane); (O).kf[ks] = glb_frag(DNK + (size_t)unit_ * 8192, 2, w, kk, lane); } \
        _Pragma("unroll") for (int r = 0; r < 4; ++r) (O).uu[r] = (unsigned)DNU[(size_t)(row0_ + ri + 4 * g + r) * 512 + h * 128 + 32 * s4 + 16 * et + lc]; \
        (O).gl = DNGL[unit_]; } while (0)
    Ops opA, opB; DN_LOAD(opA, 0);
#define DN_STEP(cur, pf, n_) do { const int n = (n_); \
        const int ck = sample ? NPCH + stream : stream * NCH + n, row0 = sample ? MP + 32 * stream : ck * 64; \
        LAS unsigned char* STp = ST + (n & 1) * 13312; LAS unsigned char* VTp = VT + (n & 1) * 13312;        \
        _Pragma("unroll") for (int t = 0; t < 2; ++t) { u32x2 p; p.x = pk2(S[t][0], S[t][1]); p.y = pk2(S[t][2], S[t][3]); *(LAS u32x2*)(STp + (16 * t + lc) * LD136 + (16 * w + 4 * g) * 2) = p; } \
        const float eg = __expf((cur).gl); \
        LDS_SYNC(); \
        f32x4 vn = (f32x4){0.f, 0.f, 0.f, 0.f}, o = (f32x4){0.f, 0.f, 0.f, 0.f}; \
        if (v12) { \
            _Pragma("unroll") for (int ks = 0; ks < 4; ++ks) { const bf16x8 bs = lds_rowfrag(STp, LD136, 16 * et, 32 * ks, lane); vn = mfma16((cur).wf[ks], bs, vn); o = mfma16((cur).qf[ks], bs, o); } \
            _Pragma("unroll") for (int r = 0; r < 4; ++r) vn[r] = bflo((cur).uu[r]) - vn[r]; \
            u32x2 p; p.x = pk2(vn[0], vn[1]); p.y = pk2(vn[2], vn[3]); *(LAS u32x2*)(VTp + (16 * et + lc) * LD72 + (16 * it + 4 * g) * 2) = p; } \
        LDS_SYNC(); \
        if (n + 1 < nsteps) DN_LOAD(pf, n + 1); \
        if (v12) { \
            for (int ks = 0; ks < C / 32; ++ks) o = mfma16((cur).af[ks], lds_rowfrag(VTp, LD72, 16 * et, 32 * ks, lane), o); \
            _Pragma("unroll") for (int r = 0; r < 4; ++r) DNO[(size_t)(row0 + 16 * it + 4 * g + r) * 512 + h * 128 + 32 * s4 + 16 * et + lc] = o[r]; } \
        _Pragma("unroll") for (int t = 0; t < 2; ++t) { S[t] = S[t] * eg; for (int ks = 0; ks < C / 32; ++ks) S[t] = mfma16((cur).kf[ks], lds_rowfrag(VTp, LD72, 16 * t, 32 * ks, lane), S[t]); } \
        } while (0)
    for (int n2 = 0; n2 < nsteps; n2 += 2) { DN_STEP(opA, opB, n2); if (n2 + 1 < nsteps) DN_STEP(opB, opA, n2 + 1); }
#undef DN_STEP
    LDS_SYNC();
#undef DN_LOAD
    float* so = X.out + (sample ? O_DNS + ((size_t)(l * DB + stream) * 4 + h) * 16384 : O_DNP + ((size_t)(l * BATCH + stream) * 4 + h) * 16384);
#pragma unroll
    for (int t = 0; t < 2; ++t)
#pragma unroll
        for (int r = 0; r < 4; ++r) so[(16 * w + 4 * g + r) * 128 + 32 * s4 + 16 * t + lc] = S[t][r];
}
DEV void ret_scan_job(const Ctx& X, int l, int job) {
    const int sh = job >> 2, q = job & 3, e0 = q * 4096 + X.tid * 8; float* U = (float*)(X.ws + WS_U);
    if (sh < BATCH * 4) { const int b = sh >> 2, h = sh & 3; const float gC = __expf(ret_log_g(h) * 64.f); f32x4 r0 = (f32x4){0.f, 0.f, 0.f, 0.f}, r1 = r0;
        constexpr int RB = (NCH % 8 == 0) ? 8 : 4;
        for (int n0 = 0; n0 < NCH; n0 += RB) { f32x4 u0[RB], u1[RB];
#pragma unroll
            for (int k = 0; k < RB; ++k) { const float* p = U + (size_t)((b * NCH + n0 + k) * 4 + h) * 16384 + e0; u0[k] = *(const f32x4*)p; u1[k] = *(const f32x4*)(p + 4); }
#pragma unroll
            for (int k = 0; k < RB; ++k) { float* p = U + (size_t)((b * NCH + n0 + k) * 4 + h) * 16384 + e0; *(f32x4*)p = r0; *(f32x4*)(p + 4) = r1; r0 = r0 * gC + u0[k]; r1 = r1 * gC + u1[k]; } }
        float* o = X.out + O_RETP + ((size_t)(l * BATCH + b) * 4 + h) * 16384 + e0; *(f32x4*)o = r0; *(f32x4*)(o + 4) = r1; }
    else { const int sb = (sh - BATCH * 4) >> 2, h = sh & 3; const float gC = __expf(ret_log_g(h) * 32.f); const float* s0 = INP(I_SRET) + ((size_t)(l * DB + sb) * 4 + h) * 16384 + e0;
        float* p = U + (size_t)((NPCH + sb) * 4 + h) * 16384 + e0; const f32x4 a0 = *(const f32x4*)s0, a1 = *(const f32x4*)(s0 + 4), u0 = *(f32x4*)p, u1 = *(f32x4*)(p + 4);
        *(f32x4*)p = a0; *(f32x4*)(p + 4) = a1; float* o = X.out + O_RETS + ((size_t)(l * DB + sb) * 4 + h) * 16384 + e0; *(f32x4*)o = a0 * gC + u0; *(f32x4*)(o + 4) = a1 * gC + u1; }
}
DEV void lru_scan_job(const Ctx& X, int l, int job) {
    const float* LRA = (const float*)(X.ws + WS_LRA); const float* LRH = (const float*)(X.ws + WS_LRH); const int ch = X.tid;
    if (job < BATCH) { const int b = job; float carry = 0.f; float* LRC = (float*)(X.ws + WS_LRC);
        float ca[NCH], chh[NCH];
#pragma unroll
        for (int n = 0; n < NCH; ++n) { const size_t last = (size_t)((b * NCH + n) * 64 + 63) * 512 + ch; ca[n] = LRA[last]; chh[n] = LRH[last]; }
#pragma unroll
        for (int n = 0; n < NCH; ++n) { LRC[(size_t)(b * NCH + n) * 512 + ch] = carry; carry = ca[n] * carry + chh[n]; }
        X.out[O_LHP + (size_t)(l * BATCH + b) * 512 + ch] = carry; }
    else { const int sb = job - BATCH; const size_t last = (size_t)(MP + 32 * sb + 31) * 512 + ch; X.out[O_LHS + (size_t)(l * DB + sb) * 512 + ch] = LRA[last] * INP(I_SLH)[(size_t)(l * DB + sb) * 512 + ch] + LRH[last]; }
}
DEV void sg_out_job(const Ctx& X, int l, int job) {
    int row0, C, h; if (job < BATCH * (SEQ / 128) * 4) { h = job & 3; row0 = (job >> 2) * 128; C = 128; } else { const int j2 = job - BATCH * (SEQ / 128) * 4; h = j2 & 3; row0 = MP + 32 * (j2 >> 2); C = 32; }
    const bf16* VN = (const bf16*)(X.ws + WS_VN); const bf16* P = (const bf16*)(X.ws + WS_HP); bf16* MRG = (bf16*)(X.ws + WS_MRG);
    const bf16* Wm = (const bf16*)(X.ws + WS_SGW) + (size_t)(l * 4 + h) * 16384; LAS unsigned char* Vs = X.lds;
    for (int idx = X.tid; idx < C * 16; idx += NTHREADS) { const int j = idx >> 4, o = (idx & 15) * 8; *(LAS u32x4*)(Vs + j * LD136 + o * 2) = *(const u32x4*)(VN + (size_t)(row0 + j) * 512 + h * 128 + o); }
    LDS_SYNC();
    LAS float* Os = (LAS float*)(X.lds + 34816);
    for (int it = X.wave; it < C / 16; it += NWAVES) { f32x4 acc[8];
#pragma unroll
        for (int t = 0; t < 8; ++t) acc[t] = (f32x4){0.f, 0.f, 0.f, 0.f};
        const int nks = (C == 128 && it < 4) ? 2 : C / 32;
        for (int ks = 0; ks < nks; ++ks) { const bf16x8 a = glb_frag(Wm, 4, it, ks, X.lane);
#pragma unroll
            for (int t = 0; t < 8; ++t) acc[t] = mfma16(a, lds_trfrag(Vs, LD136, 32 * ks, 16 * t, X.lane), acc[t]); }
#pragma unroll
        for (int r = 0; r < 4; ++r) { const int i = 16 * it + 4 * (X.lane >> 4) + r; const float bs = INP(I_SGBS)[(size_t)(l * 4 + h) * 128 + i];
#pragma unroll
            for (int t = 0; t < 8; ++t) Os[i * 132 + 16 * t + (X.lane & 15)] = acc[t][r] + bs; } }
    LDS_SYNC();
    for (int idx = X.tid; idx < C * 8; idx += NTHREADS) { const int i = idx >> 3, e0 = (idx & 7) * 16; float cu[16], o[16];
        const bf16* pc = P + (size_t)(row0 + i) * NPROJ + 3072 + h * 128 + e0; unpack8(*(const u32x4*)pc, cu); unpack8(*(const u32x4*)(pc + 8), cu + 8);
#pragma unroll
        for (int k = 0; k < 16; ++k) o[k] = geluf_(cu[k]) * Os[i * 132 + e0 + k];
        bf16* dst = MRG + (size_t)(row0 + i) * D + 1024 + h * 128 + e0; *(u32x4*)dst = pack8(o); *(u32x4*)(dst + 8) = pack8(o + 8); }
    LDS_SYNC();
}

DEV void ret_out_unit(const Ctx& X, int l, int ck, int h) {
    const Chunk c = chunk_of(ck); const bf16* P = (const bf16*)(X.ws + WS_HP); const float* rot = (const float*)(X.ws + WS_ROT); const float lg = ret_log_g(h);
    LAS unsigned char* Qs = X.lds; LAS unsigned char* Ks = X.lds + 17408; LAS unsigned char* Vs = X.lds + 34816; LAS unsigned char* Ss = X.lds + 52224; LAS unsigned char* Ps = X.lds + 87040; LAS float* Os = (LAS float*)(X.lds + 96256);
    for (int idx = X.tid; idx < c.C * 8; idx += NTHREADS) { const int j = idx >> 3, d = (idx & 7) * 8; const bf16* pr = P + (size_t)(c.row0 + j) * NPROJ + h * 128; const float* rr = rot + (size_t)(c.rot0 + j) * 128;
        rot_piece(pr, rr, d, 1.f, Qs, j); rot_piece(pr + 512, rr, d, 0.08838834764831845f, Ks, j); }
    for (int idx = X.tid; idx < c.C * 16; idx += NTHREADS) { const int j = idx >> 4, o = (idx & 15) * 8; *(LAS u32x4*)(Vs + j * LD136 + o * 2) = *(const u32x4*)(P + (size_t)(c.row0 + j) * NPROJ + 1024 + h * 128 + o); }
    { const float* U = (const float*)(X.ws + WS_U) + (size_t)(ck * 4 + h) * 16384;
      for (int idx = X.tid; idx < 128 * 16; idx += NTHREADS) { const int d = idx >> 4, o = (idx & 15) * 8; const f32x4 a = *(const f32x4*)(U + d * 128 + o), b = *(const f32x4*)(U + d * 128 + o + 4);
          u32x4 p; p.x = pk2(a.x, a.y); p.y = pk2(a.z, a.w); p.z = pk2(b.x, b.y); p.w = pk2(b.z, b.w); *(LAS u32x4*)(Ss + d * LD136 + o * 2) = p; } }
    LDS_SYNC();
    { const int nt = c.C / 16;
      for (int tt = X.wave; tt < nt * nt; tt += NWAVES) { const int it = tt / nt, jt = tt % nt; f32x4 acc = (f32x4){0.f, 0.f, 0.f, 0.f};
          if (jt <= it) {
#pragma unroll
              for (int ks = 0; ks < 4; ++ks) acc = mfma16(lds_rowfrag(Qs, LD136, 16 * it, 32 * ks, X.lane), lds_rowfrag(Ks, LD136, 16 * jt, 32 * ks, X.lane), acc); }
          const int j = 16 * jt + (X.lane & 15);
#pragma unroll
          for (int r = 0; r < 4; ++r) { const int i = 16 * it + 4 * (X.lane >> 4) + r; *(LAS bf16*)(Ps + i * LD72 + j * 2) = (bf16)((j <= i) ? f2bf(acc[r] * __expf(lg * (float)(i - j))) : 0u); } } }
    LDS_SYNC();
    { const int et = X.wave;
      for (int it = 0; it < c.C / 16; ++it) { f32x4 acc = (f32x4){0.f, 0.f, 0.f, 0.f};
#pragma unroll
          for (int ks = 0; ks < 4; ++ks) acc = mfma16(lds_rowfrag(Qs, LD136, 16 * it, 32 * ks, X.lane), lds_trfrag(Ss, LD136, 32 * ks, 16 * et, X.lane), acc);
#pragma unroll
          for (int r = 0; r < 4; ++r) acc[r] *= __expf(lg * (float)(16 * it + 4 * (X.lane >> 4) + r + 1));
          for (int ks = 0; ks < c.C / 32; ++ks) acc = mfma16(lds_rowfrag(Ps, LD72, 16 * it, 32 * ks, X.lane), lds_trfrag(Vs, LD136, 32 * ks, 16 * et, X.lane), acc);
#pragma unroll
          for (int r = 0; r < 4; ++r) Os[(16 * it + 4 * (X.lane >> 4) + r) * 132 + 16 * et + (X.lane & 15)] = acc[r]; } }
    LDS_SYNC();
    { const int t0 = X.tid >> 3, part = X.tid & 7, t = t0 < c.C ? t0 : c.C - 1; float o[16]; float s = 0.f;
#pragma unroll
      for (int i = 0; i < 16; ++i) { o[i] = Os[t * 132 + 16 * part + i]; s += o[i]; }
      s += SHFL_XOR(s, 1); s += SHFL_XOR(s, 2); s += SHFL_XOR(s, 4); const float mean = s * (1.f / 128.f); float s2 = 0.f;
#pragma unroll
      for (int i = 0; i < 16; ++i) { o[i] -= mean; s2 += o[i] * o[i]; }
      s2 += SHFL_XOR(s2, 1); s2 += SHFL_XOR(s2, 2); s2 += SHFL_XOR(s2, 4); const float rstd = 1.f / sqrtf(s2 * (1.f / 128.f) + LN_EPS);
      if (t0 < c.C) { const int row = c.row0 + t, cc = h * 128 + 16 * part; float ag[16]; const bf16* pg = P + (size_t)row * NPROJ + 1536 + cc; unpack8(*(const u32x4*)pg, ag); unpack8(*(const u32x4*)(pg + 8), ag + 8);
          const float* gn = INP(I_RETG) + l * 512 + cc;
#pragma unroll
          for (int i = 0; i < 16; ++i) o[i] = o[i] * rstd * gn[i] * siluf_(ag[i]);
          bf16* dst = (bf16*)(X.ws + WS_MRG) + (size_t)row * D + cc; *(u32x4*)dst = pack8(o); *(u32x4*)(dst + 8) = pack8(o + 8); } }
    LDS_SYNC();
}
DEV void m3_rows(const Ctx& X, int l, int rgw, int rngw) {
    const bf16* P = (const bf16*)(X.ws + WS_HP); bf16* MRG = (bf16*)(X.ws + WS_MRG); const float* LRA = (const float*)(X.ws + WS_LRA); const float* LRH = (const float*)(X.ws + WS_LRH);
    const float* LRC = (const float*)(X.ws + WS_LRC); const float* DNO = (const float*)(X.ws + WS_DNO); const int c8 = 8 * X.lane;
    for (int row = rgw; row < M; row += rngw) {
        { const float* cr = row < MP ? LRC + (size_t)(row >> 6) * 512 + c8 : INP(I_SLH) + (size_t)(l * DB + ((row - MP) >> 5)) * 512 + c8; float by[8], o[8]; unpack8(*(const u32x4*)(P + (size_t)row * NPROJ + 2048 + c8), by);
#pragma unroll
          for (int i = 0; i < 8; ++i) o[i] = (LRA[(size_t)row * 512 + c8 + i] * cr[i] + LRH[(size_t)row * 512 + c8 + i]) * geluf_(by[i]);
          *(u32x4*)(MRG + (size_t)row * D + 512 + c8) = pack8(o); }
        { float o[8], z[8]; float ss = 0.f; unpack8(*(const u32x4*)(P + (size_t)row * NPROJ + 5632 + c8), z);
#pragma unroll
          for (int i = 0; i < 8; ++i) { o[i] = DNO[(size_t)row * 512 + c8 + i]; ss += o[i] * o[i]; }
          ss += SHFL_XOR(ss, 1); ss += SHFL_XOR(ss, 2); ss += SHFL_XOR(ss, 4); ss += SHFL_XOR(ss, 8); const float rms = 1.f / sqrtf(ss * (1.f / 128.f) + LN_EPS);
          const float* gn = INP(I_DNG) + l * 128 + (c8 & 127);
#pragma unroll
          for (int i = 0; i < 8; ++i) o[i] = o[i] * rms * gn[i] * siluf_(z[i]);
          *(u32x4*)(MRG + (size_t)row * D + 1536 + c8) = pack8(o); } }
    { const size_t gt = (size_t)X.wg * NTHREADS + X.tid, GT = (size_t)X.G * NTHREADS;
      for (size_t i = gt; i < (size_t)(BATCH + DB) * 3 * 1536; i += GT) { const int cc = (int)(i % 1536), tt = (int)((i / 1536) % 3), s = (int)(i / 4608);
          if (s < BATCH) X.out[O_DCP + ((size_t)(l * BATCH + s) * 3 + tt) * 1536 + cc] = bf2f(P[(size_t)(s * SEQ + SEQ - 3 + tt) * NPROJ + 4096 + cc]);
          else X.out[O_DCS + ((size_t)(l * DB + (s - BATCH)) * 3 + tt) * 1536 + cc] = bf2f(P[(size_t)(MP + 32 * (s - BATCH) + 29 + tt) * NPROJ + 4096 + cc]); } }
}

#ifndef MK_PER_PHASE
#define MK_PER_PHASE 0
#endif
constexpr int NPHASE = 25;
#define IN(k) (lo <= (k) && (k) < hi)
#define SEAM(k) do { if (!MK_PER_PHASE && IN((k) + 1)) { xcd_barrier(bar); if (PROBE_K == 50) xcd_barrier(bar); } } while (0)
#ifndef PROBE_K
#define PROBE_K (-1)
#endif
#ifdef HOST_EMU
#define PH_BEGIN(k) ((void)0)
#define PH_END(k) ((void)0)
#else
#define PH_BEGIN(k) unsigned long long _pt0 = 0; if (PROBE_K == (k)) _pt0 = __builtin_amdgcn_s_memrealtime()
#define PH_END(k) do { if (PROBE_K == (k)) { const unsigned long long _pt1 = __builtin_amdgcn_s_memrealtime(); while (__builtin_amdgcn_s_memrealtime() - _pt1 < 4ull * (_pt1 - _pt0)) __builtin_amdgcn_s_sleep(8); } } while (0)
#endif
template <int l> DEV void layer_phases(const Ctx& X, const XcdBarrier& bar, const int lo, const int hi) {
    bf16* XB = (bf16*)(X.ws + WS_XB); bf16* HB = (bf16*)(X.ws + WS_HP); bf16* MRG = (bf16*)(X.ws + WS_MRG); const float* STAT = (const float*)(X.ws + WS_STAT);
    float* Zk0 = (float*)(X.ws + (((3 * l + 0) & 1) ? WS_XC : WS_Z)); float* Zk1 = (float*)(X.ws + (((3 * l + 1) & 1) ? WS_XC : WS_Z)); float* Zk2 = (float*)(X.ws + (((3 * l + 2) & 1) ? WS_XC : WS_Z));
    const float* gprev = l ? INP(I_LN3G) + (l - 1) * D : nullptr; const float* bprev = l ? INP(I_LN3B) + (l - 1) * D : nullptr;
        const int pb = 1 + 12 * l;
        if (IN(pb + 0)) { PH_BEGIN(0); pg8::Gemm g{XB, (const bf16*)(X.ws + WS_W1I), M, 2 * FF, D, D}; pg8::StaticOrder S; S.init(M, 2 * FF, X.G, X.wg); EpiSwiglu E{HB};
            pg8::gemm_phase<EpiSwiglu, pg8::StaticOrder, true, true>(X.lds, g, S, E);
            TAIL_BEGIN((M / 256) * (2 * FF / 256)) if (l == 0) { TAIL_CONV(0, T_WMO, 0, CV_ALL) TAIL_CONV(0, T_W2I, 0, 3900) } else { TAIL_CONV(l, T_W2I, 3000, 9000) } TAIL_END
            SEAM(pb + 0); PH_END(0); }
        if (IN(pb + 1)) { PH_BEGIN(1); pg8::Gemm g{HB, (const bf16*)(X.ws + WS_W1O), MP, D, FF, FF}; pg8::StaticOrder S; S.init(MP, D, X.G, X.wg); EpiResid E{l == 0 ? INP(I_XP) : nullptr, Zk1  , STAT, gprev, bprev, Zk0, 0.5f};
            pg8::gemm_phase<EpiResid, pg8::StaticOrder, true, true>(X.lds, g, S, E);
            pg8::Gemm g2{HB, (const bf16*)(X.ws + WS_W1O), M, D, KS_FF, FF}; pg8::SplitOrder S2; S2.init(MP / 256, MS / 256, D / 256, FF / KS_FF, KS_FF, X.G, X.wg); EpiPart E2{(float*)(X.ws + WS_PART), KS_FF};
            pg8::gemm_phase<EpiPart, pg8::SplitOrder, true, true>(X.lds, g2, S2, E2);
            TAIL_BEGIN((MS / 256) * (D / 256) * (FF / KS_FF)) if (l == 0) { TAIL_CONV(0, T_W2I, 3900, 6900) } else { TAIL_CONV(l, T_W2I, 9000, CV_ALL) TAIL_CONV(l, T_W2O, 0, 700) } TAIL_END
            SEAM(pb + 1); PH_END(1); }
        if (IN(pb + 2)) { PH_BEGIN(2); ln_phase(X, Zk0, INP(I_LN1G) + l * D, INP(I_LN1B) + l * D, nullptr, true, l == 0 ? INP(I_XS) : nullptr, Zk1, gprev, bprev, 0.5f, FF / KS_FF); SEAM(pb + 2); PH_END(2); }
        if (IN(pb + 3)) { PH_BEGIN(3); pg8::Gemm g{XB, (const bf16*)(X.ws + WS_WMI), M, NPADW, D, D}; pg8::StaticOrder S; S.init(M, NPADW, X.G, X.wg); EpiProj E{HB, (float*)(X.ws + WS_GAB)};
            pg8::gemm_phase<EpiProj, pg8::StaticOrder, true, true>(X.lds, g, S, E);
            TAIL_BEGIN((M / 256) * (NPADW / 256)) if (l == 0) { TAIL_CONV(0, T_W2I, 6900, CV_ALL) TAIL_CONV(0, T_W2O, 0, CV_ALL) if (DEPTH > 1) TAIL_CONV(1, T_W1I, 0, 3000) } else { TAIL_CONV(l, T_W2O, 700, CV_ALL) } TAIL_END
            SEAM(pb + 3); PH_END(3); }
        const bool BAL = (X.G == 256) && (NCHUNK * 4 == 576);
        if (IN(pb + 4)) { PH_BEGIN(4);
            { PH_BEGIN(20); sg_ln_rows(X, l); PH_END(20); }
            { PH_BEGIN(21); if (BAL) { ret_u_unit(X, X.wg >> 2, X.wg & 3); { const int u = 256 + X.wg; ret_u_unit(X, u >> 2, u & 3); } if (X.wg >= 192) { const int u = 512 + (X.wg - 192); ret_u_unit(X, u >> 2, u & 3); } }
              else for (int u = (X.wg + X.G - (X.G / 2) % X.G) % X.G; u < NCHUNK * 4; u += X.G) ret_u_unit(X, u >> 2, u & 3); PH_END(21); }
            { PH_BEGIN(22); for (int u = X.wg; u < NCHUNK * 4; u += X.G) dn_prep_unit(X, l, u >> 2, u & 3); PH_END(22); }
            { PH_BEGIN(23); if (BAL) { lru_prep_unit(X, l, X.wg >> 2, X.wg & 3); if (X.wg >= 64) { const int u = 256 + (X.wg - 64); lru_prep_unit(X, l, u >> 2, u & 3); } if (X.wg >= 64 && X.wg < 192) { const int u = 448 + (X.wg - 64); lru_prep_unit(X, l, u >> 2, u & 3); } }
              else for (int u = (X.wg + X.G - (X.G / 4) % X.G) % X.G; u < NCHUNK * 4; u += X.G) lru_prep_unit(X, l, u >> 2, u & 3); PH_END(23); }
            SEAM(pb + 4); PH_END(4); }
        if (IN(pb + 5)) { PH_BEGIN(5);
            constexpr int NDNP = BATCH * 16, NDNS = DB * 16, NRET = (BATCH + DB) * 16, NLRU = BATCH + DB, NSGJ = BATCH * (SEQ / 128) * 4 + DB * 4, NJOB = NDNP + NDNS + NRET + NLRU + NSGJ;
            const bool dedicated = X.G > NDNP; int j0, js;
            if (dedicated && X.wg < NDNP) { j0 = X.wg; js = NJOB; } else if (dedicated) { j0 = NDNP + (X.wg - NDNP); js = X.G - NDNP; } else { j0 = X.wg; js = X.G; }
            unsigned long long _pt0b = 0; if (PROBE_K == 31 || PROBE_K == 30) _pt0b = __builtin_amdgcn_s_memrealtime();
            if (dedicated) { if (X.wg < NDNP) dn_seq_unit(X, l, false, X.wg >> 4, (X.wg >> 2) & 3, X.wg & 3); }
            else for (int r = X.wg; r < NDNP; r += X.G) dn_seq_unit(X, l, false, r >> 4, (r >> 2) & 3, r & 3);
            if (!dedicated) j0 = NDNP + X.wg;
            for (int j = (dedicated && X.wg < NDNP) ? NJOB : j0; j < NJOB; j += js) { int r = j - NDNP;
                if (r < NDNS) { dn_seq_unit(X, l, true, r >> 4, (r >> 2) & 3, r & 3); continue; } r -= NDNS;
                if (r < NRET) { ret_scan_job(X, l, r); continue; } r -= NRET;
                if (r < NLRU) { lru_scan_job(X, l, r); continue; } r -= NLRU;
                sg_out_job(X, l, r); }
            if (dedicated && X.wg < NDNP && PROBE_K == 30) { const unsigned long long _pt1 = __builtin_amdgcn_s_memrealtime(); while (__builtin_amdgcn_s_memrealtime() - _pt1 < 4ull * (_pt1 - _pt0b)) __builtin_amdgcn_s_sleep(8); }
            if (!dedicated || X.wg >= NDNP) { const int cgw = dedicated ? (X.wg - NDNP) * NWAVES + X.wave : X.gw, cng = dedicated ? (X.G - NDNP) * NWAVES : X.NGW;
                __syncthreads();
                if (l + 1 < DEPTH) { conv_task(X, l + 1, T_W1I, 3000, CV_ALL, cgw, cng); conv_task(X, l + 1, T_W1O, 0, CV_ALL, cgw, cng); }
                if (PROBE_K == 31) { const unsigned long long _pt1 = __builtin_amdgcn_s_memrealtime(); while (__builtin_amdgcn_s_memrealtime() - _pt1 < 4ull * (_pt1 - _pt0b)) __builtin_amdgcn_s_sleep(8); } }
            SEAM(pb + 5); PH_END(5); }
        if (IN(pb + 6)) { PH_BEGIN(6); for (int u = (X.wg + X.G - (3 * X.G / 4) % X.G) % X.G; u < NCHUNK * 4; u += X.G) ret_out_unit(X, l, u >> 2, u & 3);
            if (BAL) { if (X.wg < 192) m3_rows(X, l, X.wg * NWAVES + X.wave, 192 * NWAVES); else m3_rows(X, l, M, 1); }
            else m3_rows(X, l, X.gw, X.NGW);
            SEAM(pb + 6); PH_END(6); }
        if (IN(pb + 7)) { PH_BEGIN(7); pg8::Gemm g{MRG, (const bf16*)(X.ws + WS_WMO), MP, D, D, D}; pg8::StaticOrder S; S.init(MP, D, X.G, X.wg); EpiResid E{nullptr, Zk0, STAT, INP(I_LN1G) + l * D, INP(I_LN1B) + l * D, Zk1, 1.0f};
            pg8::gemm_phase<EpiResid, pg8::StaticOrder, true, true>(X.lds, g, S, E);
            pg8::Gemm g2{MRG, (const bf16*)(X.ws + WS_WMO), M, D, KS_D, D}; pg8::SplitOrder S2; S2.init(MP / 256, MS / 256, D / 256, D / KS_D, KS_D, X.G, X.wg); EpiPart E2{(float*)(X.ws + WS_PART), KS_D};
            pg8::gemm_phase<EpiPart, pg8::SplitOrder, true, true>(X.lds, g2, S2, E2);
            TAIL_BEGIN((MS / 256) * (D / 256) * (D / KS_D)) if (l + 1 < DEPTH) { TAIL_CONV(l + 1, T_WMI, 0, 3700) } TAIL_END
            SEAM(pb + 7); PH_END(7); }
        if (IN(pb + 8)) { PH_BEGIN(8); ln_phase(X, Zk1, INP(I_LN2G) + l * D, INP(I_LN2B) + l * D, nullptr, true, nullptr, Zk0, INP(I_LN1G) + l * D, INP(I_LN1B) + l * D, 1.0f, D / KS_D); SEAM(pb + 8); PH_END(8); }
        if (IN(pb + 9)) { PH_BEGIN(9); pg8::Gemm g{XB, (const bf16*)(X.ws + WS_W2I), M, 2 * FF, D, D}; pg8::StaticOrder S; S.init(M, 2 * FF, X.G, X.wg); EpiSwiglu E{HB};
            pg8::gemm_phase<EpiSwiglu, pg8::StaticOrder, true, true>(X.lds, g, S, E);
            TAIL_BEGIN((M / 256) * (2 * FF / 256)) if (l + 1 < DEPTH) { TAIL_CONV(l + 1, T_WMI, 3700, CV_ALL) TAIL_CONV(l + 1, T_WMO, 0, CV_ALL) } TAIL_END
            SEAM(pb + 9); PH_END(9); }
        if (IN(pb + 10)) { PH_BEGIN(10); pg8::Gemm g{HB, (const bf16*)(X.ws + WS_W2O), MP, D, FF, FF}; pg8::StaticOrder S; S.init(MP, D, X.G, X.wg); EpiResid E{nullptr, Zk1, STAT, INP(I_LN2G) + l * D, INP(I_LN2B) + l * D, Zk2, 0.5f};
            pg8::gemm_phase<EpiResid, pg8::StaticOrder, true, true>(X.lds, g, S, E);
            pg8::Gemm g2{HB, (const bf16*)(X.ws + WS_W2O), M, D, KS_FF, FF}; pg8::SplitOrder S2; S2.init(MP / 256, MS / 256, D / 256, FF / KS_FF, KS_FF, X.G, X.wg); EpiPart E2{(float*)(X.ws + WS_PART), KS_FF};
            pg8::gemm_phase<EpiPart, pg8::SplitOrder, true, true>(X.lds, g2, S2, E2);
            TAIL_BEGIN((MS / 256) * (D / 256) * (FF / KS_FF)) if (l + 1 < DEPTH) { TAIL_CONV(l + 1, T_W2I, 0, 3000) } TAIL_END
            SEAM(pb + 10); PH_END(10); }
        if (IN(pb + 11)) { PH_BEGIN(11); ln_phase(X, Zk2, INP(I_LN3G) + l * D, INP(I_LN3B) + l * D, l == DEPTH - 1 ? X.out : nullptr, l != DEPTH - 1, nullptr, Zk1, INP(I_LN2G) + l * D, INP(I_LN2B) + l * D, 0.5f, FF / KS_FF); SEAM(pb + 11); PH_END(11); }
}
struct Args { const float* in[N_IN]; float* out; unsigned char* ws; int ph_lo, ph_hi; };
__global__ void __launch_bounds__(NTHREADS, 2) fwd(Args args) {
    LDS_DECL(lds);
    Ctx X; X.lds = (LAS unsigned char*)lds; X.tid = threadIdx.x; X.lane = X.tid & 63; X.wave = __builtin_amdgcn_readfirstlane(X.tid >> 6); X.wg = blockIdx.x; X.G = gridDim.x;
    X.gw = X.wg * NWAVES + X.wave; X.NGW = X.G * NWAVES; X.out = args.out; X.ws = args.ws;
    volatile LAS unsigned* MISC = (volatile LAS unsigned*)(X.lds + MISC_OFF);
    if (X.tid < 32) MISC[X.tid] = 0u;
    __syncthreads();
    XcdBarrier bar; bar.bar = (unsigned*)(X.ws + WS_CTL) + CW_BAR; bar.x = 0; bar.st = nullptr;
    if (!MK_PER_PHASE) bar = xcd_barrier_post((unsigned*)(X.ws + WS_CTL) + CW_BAR, MISC + 8);
    const int lo = args.ph_lo, hi = args.ph_hi;
    if (IN(0)) { PH_BEGIN(13); convert_weights(X, 0, 1 | 2, X.gw, X.NGW); prologue_misc(X); SEAM(0); PH_END(13); }
    layer_phases<0>(X, bar, lo, hi);
    layer_phases<1>(X, bar, lo, hi);
}

extern "C" void kernel_launch(void* const* d_in, const int* in_sizes, int n_in, void* d_out, int out_size, void* d_ws, size_t ws_size, hipStream_t stream) {
    static int grid = 0;
    if (grid == 0) {
        if (n_in != N_IN || (size_t)out_size != O_END || ws_size < WS_END) { fprintf(stderr, "kernel_launch: shape mismatch: n_in %d (want %d), out %d (want %zu), ws %zu (want >= %zu); nothing launched\n", n_in, (int)N_IN, out_size, (size_t)O_END, ws_size, (size_t)WS_END); grid = -1; return; }
        int dev = 0, cus = 0, per_cu = 0;
        if (hipGetDevice(&dev) != hipSuccess || hipDeviceGetAttribute(&cus, hipDeviceAttributeMultiprocessorCount, dev) != hipSuccess) { grid = -1; return; }
        if (hipFuncSetAttribute((const void*)fwd, hipFuncAttributeMaxDynamicSharedMemorySize, LDS_BYTES) != hipSuccess) { fprintf(stderr, "kernel_launch: hipFuncSetAttribute failed\n"); grid = -1; return; }
        if (hipOccupancyMaxActiveBlocksPerMultiprocessor(&per_cu, (const void*)fwd, NTHREADS, LDS_BYTES) != hipSuccess || per_cu < 1) fprintf(stderr, "kernel_launch: occupancy query reports %d\n", per_cu);
        (void)hipGetLastError();
        grid = cus;
    }
    if (grid < 0) return;
    if (hipMemsetAsync((char*)d_ws + WS_CTL, 0, CTL_ZERO_BYTES, stream) != hipSuccess) return;
    Args a{};
    for (int i = 0; i < N_IN; ++i) a.in[i] = (const float*)d_in[i];
    a.out = (float*)d_out; a.ws = (unsigned char*)d_ws;
#ifdef HOST_EMU
    g_emu_in = (const float* const*)d_in;
#endif
#if MK_PER_PHASE
    for (int p = 0; p < NPHASE; ++p) { a.ph_lo = p; a.ph_hi = p + 1;
#ifdef HOST_EMU
        if (getenv("EMU_PH_HI") && p >= atoi(getenv("EMU_PH_HI"))) break;
        fprintf(stderr, "[emu] phase %d\n", p);
#endif
        hipLaunchKernelGGL(fwd, dim3(grid), dim3(NTHREADS), LDS_BYTES, stream, a); }
#else
    a.ph_lo = 0; a.ph_hi = NPHASE;
    hipLaunchKernelGGL(fwd, dim3(grid), dim3(NTHREADS), LDS_BYTES, stream, a);
#endif
}
#ifdef HOST_EMU
extern "C" void emu_config(int* in_sizes, int* n_in, int* out_sizes, int* n_out, size_t* ws_bytes) {
    const int G = GW; int s[N_IN] = { MP * D, MS * D, DEPTH * DB * 4 * 16384, DEPTH * DB * G, DEPTH * DB * 3 * G, DEPTH * DB * 4 * 16384, DEPTH * DB * 3 * 1536,
        DEPTH * D * 2 * FF, DEPTH * FF * D, DEPTH * D, DEPTH * D, DEPTH * D * DIN, DEPTH * G, DEPTH * 4 * G, DEPTH * G, DEPTH * 8 * 4096, DEPTH * G, DEPTH * 8 * 4096, DEPTH * G, DEPTH * G,
        DEPTH * G, DEPTH * G, DEPTH * 4 * 16384, DEPTH * 4 * 128, DEPTH * 4 * 1536, DEPTH * 4, DEPTH * 4, DEPTH * 128, DEPTH * D * D, DEPTH * D, DEPTH * D, DEPTH * D * 2 * FF, DEPTH * FF * D, DEPTH * D, DEPTH * D };
    for (int i = 0; i < N_IN; ++i) in_sizes[i] = s[i]; *n_in = N_IN;
    const size_t o[14] = { O_YP, O_YS, O_RETP, O_LHP, O_LCP, O_DNP, O_DCP, O_RETS, O_LHS, O_LCS, O_DNS, O_DCS, O_SGV, O_END };
    for (int i = 0; i < 13; ++i) out_sizes[i] = (int)(o[i + 1] - o[i]); *n_out = 13; *ws_bytes = WS_END;
}
extern "C" int emu_regions(const char** names, size_t* offs, size_t* bytes, int maxn) {
    int n = 0;
#define REG(nm, off, by) do { names[n] = nm; offs[n] = off; bytes[n] = by; ++n; } while (0)
    REG("xb", WS_XB, (size_t)M * D * 2); REG("xc", WS_XC, (size_t)M * D * 4); REG("z", WS_Z, (size_t)M * D * 4); REG("hp", WS_HP, (size_t)M * NPROJ * 2); REG("gab", WS_GAB, (size_t)M * 8 * 4);
    REG("mrg", WS_MRG, (size_t)M * D * 2); REG("w1i", WS_W1I, (size_t)2 * FF * D * 2); REG("wmi", WS_WMI, (size_t)NPADW * D * 2); REG("dno", WS_DNO, (size_t)M * 512 * 4); REG("vn", WS_VN, (size_t)M * 512 * 2);
    REG("dnu", WS_DNU, (size_t)M * 512 * 2); REG("dnw", WS_DNW, (size_t)M * 512 * 2); REG("lrh", WS_LRH, (size_t)M * 512 * 4);
#undef REG
    return n;
}
#endif
```

```cpp
#ifndef HOST_EMU
#include <hip/hip_runtime.h>
#endif
#include <cstdio>
#include <cstdint>
#include <cmath>

typedef unsigned short bf16;
typedef short bf16x8 __attribute__((ext_vector_type(8)));
typedef short s16x4 __attribute__((ext_vector_type(4)));
typedef float f32x4 __attribute__((ext_vector_type(4)));
typedef float f32x2 __attribute__((ext_vector_type(2)));
typedef unsigned u32x4 __attribute__((ext_vector_type(4)));
typedef unsigned u32x2 __attribute__((ext_vector_type(2)));
#ifdef HOST_EMU
#define LAS
#define GAS
#define WAIT_VM(n) ((void)0)
#define WAIT_LGKM(n) ((void)0)
#define SHFL_XOR(v, m) emu::shfl_xor_f((v), (m))
#define SHFL_UP(v, d) emu::shfl_up_f((v), (d))
#define DS_READ_TR16(p) emu::ds_read_tr16((const void*)(p))
#define LDS_DECL(name) unsigned char* name = emu::cur->wg->lds
#define DEV inline
#define __expf expf
#else
#define LAS __attribute__((address_space(3)))
#define GAS __attribute__((address_space(1)))
#define WAIT_VM(n) asm volatile("s_waitcnt vmcnt(" #n ")" ::: "memory")
#define WAIT_LGKM(n) asm volatile("s_waitcnt lgkmcnt(" #n ")" ::: "memory")
#define SHFL_XOR(v, m) __shfl_xor((v), (m))
#define SHFL_UP(v, d) __shfl_up((v), (d))
#define DS_READ_TR16(p) __builtin_amdgcn_ds_read_tr16_b64_v4i16((LAS s16x4*)(p))
#define LDS_DECL(name) extern __shared__ __attribute__((aligned(16))) unsigned char name[]
#define DEV __device__ __forceinline__
#endif
#define RLX_AGENT __ATOMIC_RELAXED, __HIP_MEMORY_SCOPE_AGENT
#ifdef HOST_EMU
#define NT_LOAD(p) (*(p))
#else
#define NT_LOAD(p) __builtin_nontemporal_load(p)
#endif

#ifdef HOST_EMU
DEV unsigned f2bf(float f) { unsigned u = __builtin_bit_cast(unsigned, f); return (u + 0x7fffu + ((u >> 16) & 1u)) >> 16; }
#else
typedef __bf16 bf16x2_hw __attribute__((ext_vector_type(2)));
DEV unsigned f2bf(float f) { const f32x2 v = {f, 0.f}; const bf16x2_hw b = __builtin_convertvector(v, bf16x2_hw); return __builtin_bit_cast(unsigned, b) & 0xffffu; }
#endif
#ifdef HOST_EMU
DEV unsigned pk2(float lo, float hi) { return f2bf(lo) | (f2bf(hi) << 16); }
#else
DEV unsigned pk2(float lo, float hi) { const f32x2 v = {lo, hi}; const bf16x2_hw b = __builtin_convertvector(v, bf16x2_hw); return __builtin_bit_cast(unsigned, b); }
#endif
DEV float bf2f(bf16 h) { return __builtin_bit_cast(float, ((unsigned)h) << 16); }
DEV float bflo(unsigned u) { return __builtin_bit_cast(float, u << 16); }
DEV float bfhi(unsigned u) { return __builtin_bit_cast(float, u & 0xffff0000u); }
DEV f32x4 mfma16(bf16x8 a, bf16x8 b, f32x4 c) { return __builtin_amdgcn_mfma_f32_16x16x32_bf16(a, b, c, 0, 0, 0); }
DEV float rcpf_(float x) { return __builtin_amdgcn_rcpf(x); }
#ifdef HOST_EMU
DEV float rsqf_(float x) { return 1.f / sqrtf(x); }
DEV float sqrf_(float x) { return sqrtf(x); }
#else
DEV float rsqf_(float x) { return __builtin_amdgcn_rsqf(x); }
DEV float sqrf_(float x) { return __builtin_amdgcn_sqrtf(x); }
#endif
DEV float sigmoidf_(float x) { return rcpf_(1.f + __expf(-x)); }
DEV float siluf_(float x) { return x * rcpf_(1.f + __expf(-x)); }
DEV float geluf_(float x) { const float u = 0.7978845608028654f * (x + 0.044715f * x * x * x); return x * rcpf_(1.f + __expf(-2.f * u)); }
DEV float softplusf_(float x) { return fmaxf(x, 0.f) + log1pf(__expf(-fabsf(x))); }

#ifndef CFG_BATCH
#define CFG_BATCH 4
#define CFG_SEQ 2048
#define CFG_DB 16
#define CFG_FF 5632
#endif
constexpr int D = 2048, BATCH = CFG_BATCH, SEQ = CFG_SEQ, DB = CFG_DB, DS = 32, FF = CFG_FF, DEPTH = 2, PAST = 4096;
constexpr int MP = BATCH * SEQ, MS = DB * DS, M = MP + MS;
constexpr int GW = 512;
constexpr int NPROJ = 6144, NPADW = 6400, DIN = 6152;
constexpr int NCH = SEQ / 64, NPCH = BATCH * NCH, NCHUNK = NPCH + DB;
constexpr float ALPHA = 1.4142135623730951f, LN_EPS = 1e-5f;
static_assert(MP % 256 == 0 && MS % 256 == 0 && FF % 128 == 0 && SEQ % 128 == 0, "tile divisibility");

namespace pg8 {
#define PG8_LAS LAS
typedef unsigned short bf16_t;
constexpr int BM = 256, BK = 64, HALF = 128, HTB = HALF * BK * 2  , STAGE_BYTES = 8 * HTB, NXCD = 8, WGM = 8;

__host__ __device__ __forceinline__ int lds_byte(int r, int c) { const int st = (r >> 4) * 2 + (c >> 5), rr = r & 15, cc = c & 31, ob = rr * 64 + cc * 2; return st * 1024 + (ob ^ (((ob >> 9) & 1) << 5)); }
__host__ __device__ __forceinline__ void stage_rc(int b, int& R, int& C) { const int st = b / 1024, sb = b % 1024, swz = sb ^ (((sb >> 9) & 1) << 5); R = (st >> 1) * 16 + swz / 64; C = (st & 1) * 32 + (swz % 64) / 2; }
__host__ __device__ __forceinline__ int perm32(int rho) { const int n = rho >> 4, i = rho & 15; return 8 * (i >> 2) + 4 * n + (i & 3); }

struct Unit { int pm, pn, k0; };
struct Gemm { const bf16_t* A; const bf16_t* Bt; int M, N, K, ld; };

struct StaticOrder {
    int nM, nN, nwg, G, c;
    __host__ __device__ void init(int M, int N, int G_, int c_) { nM = M / BM; nN = N / BM; nwg = nM * nN; G = G_; c = c_; }
    __host__ __device__ bool next(int i, Unit& u) const {
        const long L = (long)i * G + c; if (L >= nwg) return false;
        int wgid = (int)L; { const int q = nwg / NXCD, r = nwg % NXCD, xcd = wgid % NXCD, off = wgid / NXCD; wgid = (xcd < r ? xcd * (q + 1) : r * (q + 1) + (xcd - r) * q) + off; }
        const int nig = WGM * nN, gid = wgid / nig, fm = gid * WGM, gsz = (nM - fm) < WGM ? (nM - fm) : WGM;
        u.pm = fm + ((wgid % nig) % gsz); u.pn = (wgid % nig) / gsz; u.k0 = 0; return true;
    }
    __device__ __forceinline__ void a_ready(const Unit&) const {}
    __device__ __forceinline__ void done(const Unit&) const {}
};
struct SplitOrder {
    int G, c, pm0, nN, parts, klen, total;
    __host__ __device__ void init(int pm0_, int npan, int nN_, int parts_, int klen_, int G_, int c_) { pm0 = pm0_; nN = nN_; parts = parts_; klen = klen_; G = G_; c = c_; total = npan * nN_ * parts_; }
    __host__ __device__ bool next(int i, Unit& u) const { const long L = (long)i * G + c; if (L >= total) return false; const int part = (int)(L % parts), tile = (int)(L / parts); u.pm = pm0 + tile / nN; u.pn = tile % nN; u.k0 = part * klen; return true; }
    __device__ __forceinline__ void a_ready(const Unit&) const {}
    __device__ __forceinline__ void done(const Unit&) const {}
};

template <class Epi, class Sched, bool ALIGN_EPI = false, bool SP2 = false>
__device__ __forceinline__ void gemm_phase(PG8_LAS unsigned char* lds, const Gemm g, const Sched& S, const Epi& E) {
    const int tid = threadIdx.x, wid = __builtin_amdgcn_readfirstlane(tid >> 6), lane = tid & 63, wr = wid >> 2, wc = wid & 3, fr = lane & 15, fq = lane >> 4;
    const int K = g.K, nt = K / BK;
    unsigned voffA[2], voffB[2];
#pragma unroll
    for (int i = 0; i < 2; ++i) { int R, C; stage_rc(tid * 16 + i * 8192, R, C); const int Rb = Epi::PERM ? ((R & ~31) + perm32(R & 31)) : R;
        voffA[i] = (unsigned)(R * g.ld + C) * 2u; voffB[i] = (unsigned)(Rb * g.ld + C) * 2u; }
    const size_t kstep = (size_t)(BK * 2);
    const size_t hstep = (size_t)HALF * g.ld * 2;
    const size_t tstep = 2 * hstep;
    const unsigned ldsw = (unsigned)wid * 1024u;
    const int aoff = lds_byte(wr * 64 + fr, fq * 8), boff = lds_byte(wc * 32 + fr, fq * 8);
#define PG8_SA(b, h) (((b) * 2 + (h)) * HTB)
#define PG8_SB(b, h) ((4 + (b) * 2 + (h)) * HTB)
#define PG8_STAGE(bufoff, gbase, voff) do { _Pragma("unroll") for (int _i = 0; _i < 2; ++_i) \
        __builtin_amdgcn_global_load_lds((const unsigned*)((const char*)(gbase) + (voff)[_i]), (PG8_LAS unsigned*)(lds + (bufoff) + ldsw + _i * 8192), 16, 0, 0); } while (0)
#define PG8_LDA(dst, b, h) do { _Pragma("unroll") for (int m = 0; m < 4; ++m) _Pragma("unroll") for (int k = 0; k < 2; ++k) dst[m][k] = *(const PG8_LAS bf16x8*)(lds + PG8_SA(b, h) + aoff + m * 2048 + k * 1024); } while (0)
#define PG8_LDB(dst, b, h) do { _Pragma("unroll") for (int n = 0; n < 2; ++n) _Pragma("unroll") for (int k = 0; k < 2; ++k) dst[n][k] = *(const PG8_LAS bf16x8*)(lds + PG8_SB(b, h) + boff + n * 2048 + k * 1024); } while (0)
#define PG8_MMA(ai, bj, At, Bt) do { __builtin_amdgcn_s_setprio(1); _Pragma("unroll") for (int m = 0; m < 4; ++m) _Pragma("unroll") for (int n = 0; n < 2; ++n) _Pragma("unroll") for (int k = 0; k < 2; ++k) \
        acc[ai][bj][m][n] = __builtin_amdgcn_mfma_f32_16x16x32_bf16(Bt[n][k], At[m][k], acc[ai][bj][m][n], 0, 0, 0); __builtin_amdgcn_s_setprio(0); } while (0)
#define PG8_WAIT_V(n) WAIT_VM(n)
#define PG8_WAIT_L(n) WAIT_LGKM(n)
#define PG8_BAR __builtin_amdgcn_s_barrier()
#define PG8_SCHED __builtin_amdgcn_sched_barrier(0)
    Unit cur, nxt; int ui = 0;
    if (!S.next(0, cur)) return;
    f32x4 acc[2][2][4][2];
#pragma unroll
    for (int a = 0; a < 2; ++a)
#pragma unroll
        for (int b = 0; b < 2; ++b)
#pragma unroll
            for (int m = 0; m < 4; ++m)
#pragma unroll
                for (int n = 0; n < 2; ++n) acc[a][b][m][n] = (f32x4){0.f, 0.f, 0.f, 0.f};
    bf16x8 At[4][2], B0[2][2], B1[2][2];
    const char* cA = (const char*)g.A + (size_t)cur.pm * tstep + (size_t)cur.k0 * 2; const char* cB = (const char*)g.Bt + (size_t)cur.pn * tstep + (size_t)cur.k0 * 2;
    S.a_ready(cur);
    if constexpr (SP2) {
        PG8_STAGE(PG8_SB(0, 0), cB, voffB); PG8_STAGE(PG8_SB(0, 1), cB + hstep, voffB); PG8_STAGE(PG8_SA(0, 0), cA, voffA); PG8_STAGE(PG8_SA(0, 1), cA + hstep, voffA);
        if (wr == 1) PG8_BAR;
        PG8_WAIT_V(2); PG8_BAR;
        PG8_STAGE(PG8_SB(1, 0), cB + kstep, voffB); PG8_STAGE(PG8_SA(1, 0), cA + kstep, voffA); PG8_STAGE(PG8_SB(1, 1), cB + hstep + kstep, voffB);
        PG8_WAIT_V(6); PG8_BAR;
    } else {
        PG8_STAGE(PG8_SB(0, 0), cB, voffB); PG8_STAGE(PG8_SA(0, 0), cA, voffA); PG8_STAGE(PG8_SB(0, 1), cB + hstep, voffB); PG8_STAGE(PG8_SA(0, 1), cA + hstep, voffA);
        if (wr == 1) PG8_BAR;
        PG8_WAIT_V(4); PG8_BAR;
        PG8_STAGE(PG8_SB(1, 0), cB + kstep, voffB); PG8_STAGE(PG8_SA(1, 0), cA + kstep, voffA); PG8_STAGE(PG8_SB(1, 1), cB + hstep + kstep, voffB);
        PG8_WAIT_V(6); PG8_BAR;
    }
    for (;;) {
        const bool has_next = S.next(ui + 1, nxt);
        const char* nA = has_next ? (const char*)g.A + (size_t)nxt.pm * tstep + (size_t)nxt.k0 * 2 : cA; const char* nB = has_next ? (const char*)g.Bt + (size_t)nxt.pn * tstep + (size_t)nxt.k0 * 2 : cB;
        for (int t = 0; t < nt; t += 2) {
            const bool last = (t == nt - 2);
            const char* a1 = cA + (size_t)(t + 1) * kstep;
            const char* a2 = last ? nA : cA + (size_t)(t + 2) * kstep; const char* b2 = last ? nB : cB + (size_t)(t + 2) * kstep;
            const char* a3 = a2 + kstep; const char* b3 = b2 + kstep;
            if (last && has_next) S.a_ready(nxt);
            if constexpr (SP2) {
            PG8_LDB(B0, 0, 0); PG8_LDB(B1, 0, 1); PG8_SCHED; PG8_LDA(At, 0, 0); PG8_STAGE(PG8_SA(1, 1), a1 + hstep, voffA);
            PG8_WAIT_V(8); PG8_WAIT_L(0); PG8_BAR; PG8_MMA(0, 0, At, B0); PG8_MMA(0, 1, At, B1); PG8_BAR; PG8_SCHED;
            PG8_LDA(At, 0, 1); PG8_STAGE(PG8_SB(0, 0), b2, voffB); PG8_STAGE(PG8_SB(0, 1), b2 + hstep, voffB); PG8_STAGE(PG8_SA(0, 0), a2, voffA);
            PG8_WAIT_V(8); PG8_WAIT_L(0); PG8_BAR; PG8_MMA(1, 0, At, B0); PG8_MMA(1, 1, At, B1); PG8_BAR; PG8_SCHED;
            PG8_LDB(B0, 1, 0); PG8_LDB(B1, 1, 1); PG8_SCHED; PG8_LDA(At, 1, 0); PG8_STAGE(PG8_SA(0, 1), a2 + hstep, voffA);
            PG8_WAIT_V(8); PG8_WAIT_L(0); PG8_BAR; PG8_MMA(0, 0, At, B0); PG8_MMA(0, 1, At, B1); PG8_BAR; PG8_SCHED;
            PG8_LDA(At, 1, 1); PG8_STAGE(PG8_SB(1, 0), b3, voffB); PG8_STAGE(PG8_SB(1, 1), b3 + hstep, voffB); PG8_STAGE(PG8_SA(1, 0), a3, voffA);
            PG8_WAIT_V(8); PG8_WAIT_L(0); PG8_BAR; PG8_MMA(1, 0, At, B0); PG8_MMA(1, 1, At, B1); PG8_BAR; PG8_SCHED;
            } else {
            PG8_LDB(B0, 0, 0); PG8_SCHED; PG8_LDA(At, 0, 0); PG8_STAGE(PG8_SA(1, 1), a1 + hstep, voffA);
            PG8_WAIT_L(8); PG8_BAR; PG8_WAIT_L(0); PG8_MMA(0, 0, At, B0); PG8_BAR; PG8_SCHED;
            PG8_LDB(B1, 0, 1); PG8_STAGE(PG8_SB(0, 0), b2, voffB);
            PG8_BAR; PG8_WAIT_L(0); PG8_MMA(0, 1, At, B1); PG8_BAR;
            PG8_LDA(At, 0, 1); PG8_STAGE(PG8_SA(0, 0), a2, voffA);
            PG8_BAR; PG8_WAIT_L(0); PG8_MMA(1, 0, At, B0); PG8_BAR; PG8_SCHED;
            PG8_STAGE(PG8_SB(0, 1), b2 + hstep, voffB);
            PG8_WAIT_V(6); PG8_BAR; PG8_MMA(1, 1, At, B1); PG8_BAR;
            PG8_LDB(B0, 1, 0); PG8_SCHED; PG8_LDA(At, 1, 0); PG8_STAGE(PG8_SA(0, 1), a2 + hstep, voffA);
            PG8_WAIT_L(8); PG8_BAR; PG8_WAIT_L(0); PG8_MMA(0, 0, At, B0); PG8_BAR; PG8_SCHED;
            PG8_LDB(B1, 1, 1); PG8_STAGE(PG8_SB(1, 0), b3, voffB);
            PG8_BAR; PG8_WAIT_L(0); PG8_MMA(0, 1, At, B1); PG8_BAR;
            PG8_LDA(At, 1, 1); PG8_STAGE(PG8_SA(1, 0), a3, voffA);
            PG8_BAR; PG8_WAIT_L(0); PG8_MMA(1, 0, At, B0); PG8_BAR; PG8_SCHED;
            PG8_STAGE(PG8_SB(1, 1), b3 + hstep, voffB);
            PG8_WAIT_V(6); PG8_BAR; PG8_MMA(1, 1, At, B1); PG8_BAR;
            }
        }
        if constexpr (ALIGN_EPI) { if (wr == 0) PG8_BAR; }
        if constexpr (!Epi::AFTER_DRAIN) { E(acc, cur, wr, wc, fr, fq); S.done(cur); }
        if (!has_next) break;
#pragma unroll
        for (int a = 0; a < 2; ++a)
#pragma unroll
            for (int b = 0; b < 2; ++b)
#pragma unroll
                for (int m = 0; m < 4; ++m)
#pragma unroll
                    for (int n = 0; n < 2; ++n) acc[a][b][m][n] = (f32x4){0.f, 0.f, 0.f, 0.f};
        cur = nxt; cA = nA; cB = nB; ++ui;
        if constexpr (ALIGN_EPI) { if (wr == 1) PG8_BAR; }
    }
    PG8_WAIT_V(0);
    if constexpr (!ALIGN_EPI) { if (wr == 0) PG8_BAR; }
    PG8_BAR;
    if constexpr (Epi::AFTER_DRAIN) { E.fused(acc, cur, wr, wc, fr, fq, lds, wid, lane); S.done(cur); }
#undef PG8_SA
#undef PG8_SB
#undef PG8_STAGE
#undef PG8_LDA
#undef PG8_LDB
#undef PG8_MMA
#undef PG8_WAIT_V
#undef PG8_WAIT_L
#undef PG8_BAR
#undef PG8_SCHED
}
}

constexpr size_t al256(size_t x) { return (x + 255) & ~(size_t)255; }
constexpr size_t cmax(size_t a, size_t b) { return a > b ? a : b; }
constexpr size_t WS_CTL = 0, CTL_ZERO_BYTES = 1u << 20;
constexpr size_t WS_ROT = CTL_ZERO_BYTES;
constexpr size_t WS_LRUW = WS_ROT + al256((size_t)(SEQ + 32) * 64 * 2 * 4);
constexpr size_t WS_SGW = WS_LRUW + al256((size_t)DEPTH * 2 * 8 * 4096 * 2);
constexpr size_t WS_W1I = WS_SGW + al256((size_t)DEPTH * 4 * 16384 * 2);
constexpr size_t WS_W1O = WS_W1I + al256((size_t)2 * FF * D * 2);
constexpr size_t WS_WMI = WS_W1O + al256((size_t)D * FF * 2);
constexpr size_t WS_WMO = WS_WMI + al256((size_t)NPADW * D * 2);
constexpr size_t WS_W2I = WS_WMO + al256((size_t)D * D * 2);
constexpr size_t WS_W2O = WS_W2I + al256((size_t)2 * FF * D * 2);
constexpr size_t WS_XB = WS_W2O + al256((size_t)D * FF * 2);
constexpr size_t WS_XC = WS_XB + al256((size_t)M * D * 2);
constexpr size_t WS_Z = WS_XC + al256((size_t)M * D * 4);
constexpr size_t WS_HP = WS_Z + al256((size_t)M * D * 4);
constexpr size_t WS_GAB = WS_HP + al256(cmax((size_t)M * FF * 2, (size_t)M * NPROJ * 2));
constexpr size_t WS_MRG = WS_GAB + al256((size_t)M * 8 * 4);
constexpr size_t WS_U = WS_MRG + al256((size_t)M * D * 2);
constexpr size_t WS_DNU = WS_U + al256((size_t)NCHUNK * 4 * 16384 * 4);
constexpr size_t WS_DNW = WS_DNU + al256((size_t)M * 512 * 2);
constexpr size_t WS_DNQ = WS_DNW + al256((size_t)NCHUNK * 4 * 16384);
constexpr size_t WS_DNK = WS_DNQ + al256((size_t)NCHUNK * 4 * 16384);
constexpr size_t WS_DNA = WS_DNK + al256((size_t)NCHUNK * 4 * 128 * 64 * 2);
constexpr size_t WS_DNGL = WS_DNA + al256((size_t)NCHUNK * 4 * 64 * 64 * 2);
constexpr size_t WS_DNO = WS_DNGL + al256((size_t)NCHUNK * 4 * 4);
constexpr size_t WS_LRA = WS_DNO + al256((size_t)M * 512 * 4);
constexpr size_t WS_LRH = WS_LRA + al256((size_t)M * 512 * 4);
constexpr size_t WS_LRC = WS_LRH + al256((size_t)M * 512 * 4);
constexpr size_t WS_VN = WS_LRC + al256((size_t)NPCH * 512 * 4);
constexpr size_t WS_PART = WS_VN + al256((size_t)M * 512 * 2);
constexpr size_t WS_STAT = WS_PART + al256((size_t)(FF / 512 > 4 ? FF / 512 : 4) * MS * D * 4);
constexpr size_t WS_XSLOT = WS_STAT + al256((size_t)M * 2 * 4);
constexpr size_t WS_END = WS_XSLOT + al256((size_t)MP * 8 * 8); constexpr size_t WS_END_OLD_ = WS_PART + al256((size_t)(FF / 512 > 4 ? FF / 512 : 4) * MS * D * 4);
constexpr size_t O_YP = 0, O_YS = O_YP + (size_t)MP * D, O_RETP = O_YS + (size_t)MS * D, O_LHP = O_RETP + (size_t)DEPTH * BATCH * 4 * 16384,
    O_LCP = O_LHP + (size_t)DEPTH * BATCH * 512, O_DNP = O_LCP + (size_t)DEPTH * BATCH * 3 * 512, O_DCP = O_DNP + (size_t)DEPTH * BATCH * 4 * 16384,
    O_RETS = O_DCP + (size_t)DEPTH * BATCH * 3 * 1536, O_LHS = O_RETS + (size_t)DEPTH * DB * 4 * 16384, O_LCS = O_LHS + (size_t)DEPTH * DB * 512,
    O_DNS = O_LCS + (size_t)DEPTH * DB * 3 * 512, O_DCS = O_DNS + (size_t)DEPTH * DB * 4 * 16384, O_SGV = O_DCS + (size_t)DEPTH * DB * 3 * 1536,
    O_END = O_SGV + (size_t)DEPTH * DB * 32 * 512;
constexpr int CW_TMO = 0;
constexpr int CW_PANEL = 16384;
constexpr int CW_BAR = 4096;
constexpr int RING_BYTES = 131072, LDS_BYTES = 147456, MISC_OFF = LDS_BYTES - 1024;
constexpr int NWAVES = 8, NTHREADS = 512;
enum { I_XP = 0, I_XS, I_SRET, I_SLH, I_SLC, I_SDN, I_SDC, I_W1I, I_W1O, I_LN1G, I_LN1B, I_WMI, I_RETG, I_LCW, I_LCB, I_LWA, I_LBA, I_LWX, I_LBX, I_LAM,
       I_SGG, I_SGB, I_SGW, I_SGBS, I_DCW, I_DALOG, I_DDT, I_DNG, I_WMO, I_LN2G, I_LN2B, I_W2I, I_W2O, I_LN3G, I_LN3B, N_IN };
#ifdef HOST_EMU
static const float* const* g_emu_in = nullptr;
#define INP(k) (g_emu_in[k])
#else
DEV const float* in_ptr_(int k) {
    const __attribute__((address_space(4))) char* ka = (const __attribute__((address_space(4))) char*)__builtin_amdgcn_kernarg_segment_ptr();
    const unsigned long long v = *(volatile const __attribute__((address_space(4))) unsigned long long*)(ka + 8 * k);
    return (const float*)(const GAS float*)v;
}
#define INP(k) in_ptr_(k)
#endif

#define XB_TMO      128
#define XB_XCNT(j)  (256  + 64 * (j))
#define XB_XSUB(j)  (1280 + 64 * (j))
#define XB_XGEN(j)  (2304 + 64 * (j))
#define XB_TOP      3328
#define XB_TOPGEN   3392
#define XCD_BAR_WORDS 3456
#define XB_SPIN_CAP (1u << 18)
DEV unsigned xb_ld(unsigned* p)              { return __hip_atomic_load(p, __ATOMIC_RELAXED, __HIP_MEMORY_SCOPE_AGENT); }
DEV unsigned xb_add(unsigned* p, unsigned v) { return __hip_atomic_fetch_add(p, v, __ATOMIC_RELAXED, __HIP_MEMORY_SCOPE_AGENT); }
DEV unsigned xb_xcc_id() { return (unsigned)__builtin_amdgcn_s_getreg((3 << 11) | 20) & 0xFu; }
#define XB_SPIN(cond, bar) do { unsigned _sp = 0; while (cond) { __builtin_amdgcn_s_sleep(1); \
    if ((++_sp & 255u) == 0u) { if (xb_ld(&(bar)[XB_TMO])) break; if (_sp > XB_SPIN_CAP) { atomicAdd(&(bar)[XB_TMO], 1u); break; } } } } while (0)
struct XcdBarrier { unsigned* bar; unsigned x; volatile LAS unsigned* st; };
DEV XcdBarrier xcd_barrier_post(unsigned* bar, volatile LAS unsigned* st) {
    XcdBarrier b; b.bar = bar; b.x = xb_xcc_id(); b.st = st;
    if (threadIdx.x == 0) (void)xb_add(&bar[XB_XCNT(b.x)], 1u);
    return b;
}
DEV void xcd_barrier_complete(unsigned* bar, unsigned x, unsigned& nloc, unsigned& nx) {
    const unsigned G = gridDim.x * gridDim.y * gridDim.z;
    unsigned sum, cnt, mine, sp = 0u;
    for (;;) {
        sum = 0u; cnt = 0u; mine = 0u;
#pragma unroll
        for (unsigned j = 0; j < 16; ++j) { const unsigned c = xb_ld(&bar[XB_XCNT(j)]); sum += c; cnt += (c > 0u) ? 1u : 0u; mine = (j == x) ? c : mine; }
        if (sum == G) break;
        __builtin_amdgcn_s_sleep(1);
        if ((++sp & 255u) == 0u) { if (xb_ld(&bar[XB_TMO])) break; if (sp > XB_SPIN_CAP) { atomicAdd(&bar[XB_TMO], 1u); break; } }
    }
    nloc = mine > 0u ? mine : 1u; nx = cnt > 0u ? cnt : 1u;
}
DEV void xcd_barrier(const XcdBarrier& b) {
    WAIT_VM(0);
    __syncthreads();
    if (threadIdx.x == 0) {
        unsigned* bar = b.bar;
        __builtin_amdgcn_s_waitcnt(0);
        unsigned nloc = b.st[0], nx = b.st[1];
        if (nloc == 0u) { xcd_barrier_complete(bar, b.x, nloc, nx); b.st[0] = nloc; b.st[1] = nx; }
        const unsigned old = xb_add(&bar[XB_XSUB(b.x)], 1u);
        const unsigned gen = old / nloc;
        if (old + 1u == (gen + 1u) * nloc) {
            __builtin_amdgcn_fence(__ATOMIC_RELEASE, "agent");
            WAIT_VM(0);
            const unsigned og = xb_add(&bar[XB_TOP], 1u);
            const unsigned tg = og / nx;
            if (og + 1u == (tg + 1u) * nx) xb_add(&bar[XB_TOPGEN], 1u);
            else XB_SPIN(xb_ld(&bar[XB_TOPGEN]) == tg, bar);
            __builtin_amdgcn_fence(__ATOMIC_ACQUIRE, "agent");
            xb_add(&bar[XB_XGEN(b.x)], 1u);
            WAIT_VM(0);
        } else {
            XB_SPIN(xb_ld(&bar[XB_XGEN(b.x)]) == gen, bar);
            __builtin_amdgcn_fence(__ATOMIC_ACQUIRE, "agent");
            WAIT_VM(0);
        }
    }
    __syncthreads();
}

#ifdef HOST_EMU
#define WAVE_LDS_SYNC() emu::wave_sync()
#else
#define WAVE_LDS_SYNC() do { WAIT_LGKM(0); asm volatile("" ::: "memory"); } while (0)
#endif
#ifdef HOST_EMU
#define LDS_SYNC() emu::wg_barrier()
#else
#define LDS_SYNC() do { WAIT_LGKM(0); __builtin_amdgcn_s_barrier(); asm volatile("" ::: "memory"); } while (0)
#endif
DEV float wave_sum(float v) {
#pragma unroll
    for (int o = 1; o < 64; o <<= 1) v += SHFL_XOR(v, o);
    return v;
}
DEV bf16x8 lds_rowfrag(const LAS unsigned char* T, int ldb, int r0, int k0, int lane) { return *(const LAS bf16x8*)(T + (r0 + (lane & 15)) * ldb + (k0 + 8 * (lane >> 4)) * 2); }
DEV bf16x8 lds_trfrag(const LAS unsigned char* T, int ldb, int k0, int c0, int lane) {
    const int g = lane >> 4, q = (lane & 15) >> 2, p = lane & 3;
    const LAS unsigned char* a0 = T + (k0 + 8 * g + q) * ldb + (c0 + 4 * p) * 2;
    const s16x4 lo = DS_READ_TR16(a0), hi = DS_READ_TR16(a0 + 4 * ldb);
    return (bf16x8){lo[0], lo[1], lo[2], lo[3], hi[0], hi[1], hi[2], hi[3]};
}
DEV size_t frag_off(int r, int k, int nks) { return (size_t)(((r >> 4) * nks + (k >> 5)) * 1024 + ((k & 31) >> 3) * 256 + (r & 15) * 16 + (k & 7) * 2); }
DEV bf16x8 glb_frag(const bf16* base, int nks, int rt, int ks, int lane) { return *(const bf16x8*)((const char*)base + (size_t)(rt * nks + ks) * 1024 + lane * 16); }
DEV bf16x8 glb_rowfrag(const bf16* T, size_t ld, int r0, int k0, int lane) { return *(const bf16x8*)(T + (size_t)(r0 + (lane & 15)) * ld + k0 + 8 * (lane >> 4)); }
DEV void unpack8(const u32x4 v, float* f) { f[0] = bflo(v.x); f[1] = bfhi(v.x); f[2] = bflo(v.y); f[3] = bfhi(v.y); f[4] = bflo(v.z); f[5] = bfhi(v.z); f[6] = bflo(v.w); f[7] = bfhi(v.w); }
DEV unsigned pkh2(float lo, float hi) { return (unsigned)__builtin_bit_cast(unsigned short, (_Float16)lo) | ((unsigned)__builtin_bit_cast(unsigned short, (_Float16)hi) << 16); }
DEV float hlo(unsigned u) { return (float)__builtin_bit_cast(_Float16, (unsigned short)(u & 0xffffu)); }
DEV float hhi(unsigned u) { return (float)__builtin_bit_cast(_Float16, (unsigned short)(u >> 16)); }
DEV void unpack8h(const u32x4 v, float* f) { f[0] = hlo(v.x); f[1] = hhi(v.x); f[2] = hlo(v.y); f[3] = hhi(v.y); f[4] = hlo(v.z); f[5] = hhi(v.z); f[6] = hlo(v.w); f[7] = hhi(v.w); }
DEV unsigned short f2h(float f) { return __builtin_bit_cast(unsigned short, (_Float16)f); }
DEV float h2f(unsigned short h) { return (float)__builtin_bit_cast(_Float16, h); }
DEV f32x4 ld4h(const unsigned short* p) { const u32x2 w = *(const u32x2*)p; return (f32x4){hlo(w.x), hhi(w.x), hlo(w.y), hhi(w.y)}; }
DEV u32x4 pack8h(const float* f) { u32x4 o; o.x = pkh2(f[0], f[1]); o.y = pkh2(f[2], f[3]); o.z = pkh2(f[4], f[5]); o.w = pkh2(f[6], f[7]); return o; }
DEV u32x4 pack8(const float* f) { u32x4 o; o.x = pk2(f[0], f[1]); o.y = pk2(f[2], f[3]); o.z = pk2(f[4], f[5]); o.w = pk2(f[6], f[7]); return o; }

struct Ctx {
    LAS unsigned char* lds; int tid, lane, wave, wg, G, gw, NGW;
    float* out; unsigned char* ws;
};
struct Chunk { int row0, C, rot0, stream, n; bool sample; };
DEV Chunk chunk_of(int ck) {
    Chunk c;
    if (ck < NPCH) { c.sample = false; c.stream = ck / NCH; c.n = ck % NCH; c.row0 = ck * 64; c.C = 64; c.rot0 = c.n * 64; }
    else { c.sample = true; c.stream = ck - NPCH; c.n = 0; c.row0 = MP + 32 * c.stream; c.C = 32; c.rot0 = SEQ; }
    return c;
}

DEV void conv_load(const float* W, int ldw, int k0, int n0, int nvalid, int lane, int rs, float (&v)[32]) {
    const float* base = W + (size_t)k0 * ldw + n0;
    const int c = lane & 31; const unsigned loff = (unsigned)((lane >> 5) * ldw + (c < nvalid ? c : nvalid - 1));
#pragma unroll
    for (int i = 0; i < 32; ++i) v[i] = NT_LOAD(base + (size_t)(2 * i * rs) * ldw + loff);
}
DEV void conv_store(const float (&v)[32], int nvalid, int k0, bf16* WT, int K, int drow0, LAS float* scr, int lane) {
    const bool ok = (lane & 31) < nvalid;
#pragma unroll
    for (int i = 0; i < 32; ++i) scr[(2 * i + (lane >> 5)) * 33 + (lane & 31)] = ok ? v[i] : 0.f;
    WAVE_LDS_SYNC();
    const int c = lane & 7;
#pragma unroll
    for (int j = 0; j < 4; ++j) { const int n = (lane >> 3) + 8 * j; const LAS float* s = scr + (8 * c) * 33 + n;
        u32x4 o; o.x = pk2(s[0 * 33], s[1 * 33]); o.y = pk2(s[2 * 33], s[3 * 33]); o.z = pk2(s[4 * 33], s[5 * 33]); o.w = pk2(s[6 * 33], s[7 * 33]);
        *(u32x4*)(WT + (size_t)(drow0 + n) * K + k0 + 8 * c) = o; }
    WAVE_LDS_SYNC();
}
DEV void conv_matrix(const Ctx& X, const float* W, int K, int ldw, int nblk, int lastvalid, bf16* WT, int mode, int gw, int ngw, int lo = 0, int hi = 1 << 30) {
    LAS float* scr = (LAS float*)(X.lds + X.wave * 16384);
    const int total = (K / 64) * nblk < hi ? (K / 64) * nblk : hi;
#define CONV_LD(v, i_, rs_) conv_load(W, ldw, ((i_) / nblk) * 64, ((i_) % nblk) * 32, ((i_) % nblk) == nblk - 1 ? lastvalid : 32, X.lane, (rs_), v)
#define CONV_PUT(v, i_) do { const int kb_ = (i_) / nblk, nb_ = (i_) % nblk, n0_ = nb_ * 32; int drow_ = n0_; \
        if (mode == 1) { const int up_ = n0_ >= FF, nn_ = up_ ? n0_ - FF : n0_; drow_ = 256 * (nn_ / 128) + 128 * up_ + (nn_ % 128); } \
        conv_store(v, nb_ == nblk - 1 ? lastvalid : 32, kb_ * 64, WT, K, drow_, scr, X.lane); } while (0)
    int it = lo + gw; if (it >= total) return;
    float A[32], B[32]; CONV_LD(A, it, 1);
    while (it + ngw < total) { const int i1 = it + ngw, i2 = it + 2 * ngw; const bool real = i2 < total;
        CONV_LD(B, i1, 1); __builtin_amdgcn_sched_barrier(0);
        CONV_PUT(A, it); __builtin_amdgcn_sched_barrier(0);
        CONV_LD(A, real ? i2 : i1, real ? 1 : 0); __builtin_amdgcn_sched_barrier(0);
        CONV_PUT(B, i1); __builtin_amdgcn_sched_barrier(0);
        it = i2; }
    if (it < total) CONV_PUT(A, it);
#undef CONV_LD
#undef CONV_PUT
}
DEV void conv_w1i_load(const Ctx& X, bool second, int l, int it, float (&v)[32]) { const int nblk = 2 * FF / 32; conv_load((second ? INP(I_W2I) : INP(I_W1I)) + (size_t)l * D * 2 * FF, 2 * FF, (it / nblk) * 64, (it % nblk) * 32, 32, X.lane, 1, v); }
DEV void conv_w1i_put(const Ctx& X, bool second, int it, const float (&v)[32]) { const int nblk = 2 * FF / 32; const int kb = it / nblk, n0 = (it % nblk) * 32; const int up = n0 >= FF, nn = up ? n0 - FF : n0;
    conv_store(v, 32, kb * 64, (bf16*)(X.ws + (second ? WS_W2I : WS_W1I)), D, 256 * (nn / 128) + 128 * up + (nn % 128), (LAS float*)(X.lds + X.wave * 16384), X.lane); }
DEV void convert_weights(const Ctx& X, int l, int mask, int gw, int ngw) {
    if (mask & 1) { conv_matrix(X, INP(I_W1I) + (size_t)l * D * 2 * FF, D, 2 * FF, 2 * FF / 32, 32, (bf16*)(X.ws + WS_W1I), 1, gw, ngw);
                    conv_matrix(X, INP(I_W1O) + (size_t)l * FF * D, FF, D, D / 32, 32, (bf16*)(X.ws + WS_W1O), 0, gw, ngw); }
    if (mask & 2) { bf16* WMI = (bf16*)(X.ws + WS_WMI); conv_matrix(X, INP(I_WMI) + (size_t)l * D * DIN, D, DIN, 193, 8, WMI, 0, gw, ngw);
        u32x4* z = (u32x4*)(WMI + (size_t)6176 * D); const size_t n16 = (size_t)(NPADW - 6176) * D * 2 / 16;
        for (size_t i = (size_t)gw * 64 + X.lane; i < n16; i += (size_t)ngw * 64) z[i] = (u32x4){0u, 0u, 0u, 0u}; }
    if (mask & 4) conv_matrix(X, INP(I_WMO) + (size_t)l * D * D, D, D, D / 32, 32, (bf16*)(X.ws + WS_WMO), 0, gw, ngw);
    if (mask & 8) { conv_matrix(X, INP(I_W2I) + (size_t)l * D * 2 * FF, D, 2 * FF, 2 * FF / 32, 32, (bf16*)(X.ws + WS_W2I), 1, gw, ngw);
                    conv_matrix(X, INP(I_W2O) + (size_t)l * FF * D, FF, D, D / 32, 32, (bf16*)(X.ws + WS_W2O), 0, gw, ngw); }
}
enum { T_W1I = 0, T_W1O, T_WMI, T_WMO, T_W2I, T_W2O };
constexpr int CV_ALL = 1 << 30;
#ifndef CFG_CVM1LO
#define CFG_CVM1LO 3000
#endif
constexpr int CV_M1_LO = CFG_CVM1LO, CV_M1_HI = (CV_M1_LO + NCHUNK * 4 * 8) < (D / 64) * (2 * FF / 32) ? (CV_M1_LO + NCHUNK * 4 * 8) : (D / 64) * (2 * FF / 32);
#ifndef CFG_CVM1BLO
#define CFG_CVM1BLO 5500
#endif
constexpr int CV_M1B_LO = CFG_CVM1BLO, CV_M1B_HI = (CV_M1B_LO + NCHUNK * 4 * 8) < (D / 64) * (2 * FF / 32) ? (CV_M1B_LO + NCHUNK * 4 * 8) : (D / 64) * (2 * FF / 32);
static_assert(DEPTH == 2, "the conversion plan below is laid out for two layers (first / last)");
DEV void conv_task(const Ctx& X, int l, int task, int lo, int hi, int gw, int ngw) {
    if (task == T_W1I) conv_matrix(X, INP(I_W1I) + (size_t)l * D * 2 * FF, D, 2 * FF, 2 * FF / 32, 32, (bf16*)(X.ws + WS_W1I), 1, gw, ngw, lo, hi);
    else if (task == T_W1O) conv_matrix(X, INP(I_W1O) + (size_t)l * FF * D, FF, D, D / 32, 32, (bf16*)(X.ws + WS_W1O), 0, gw, ngw, lo, hi);
    else if (task == T_WMI) { bf16* WMI = (bf16*)(X.ws + WS_WMI); conv_matrix(X, INP(I_WMI) + (size_t)l * D * DIN, D, DIN, 193, 8, WMI, 0, gw, ngw, lo, hi);
        if (hi >= (D / 64) * 193) { u32x4* z = (u32x4*)(WMI + (size_t)6176 * D); const size_t n16 = (size_t)(NPADW - 6176) * D * 2 / 16;
            for (size_t i = (size_t)gw * 64 + X.lane; i < n16; i += (size_t)ngw * 64) z[i] = (u32x4){0u, 0u, 0u, 0u}; } }
    else if (task == T_WMO) conv_matrix(X, INP(I_WMO) + (size_t)l * D * D, D, D, D / 32, 32, (bf16*)(X.ws + WS_WMO), 0, gw, ngw, lo, hi);
    else if (task == T_W2I) conv_matrix(X, INP(I_W2I) + (size_t)l * D * 2 * FF, D, 2 * FF, 2 * FF / 32, 32, (bf16*)(X.ws + WS_W2I), 1, gw, ngw, lo, hi);
    else conv_matrix(X, INP(I_W2O) + (size_t)l * FF * D, FF, D, D / 32, 32, (bf16*)(X.ws + WS_W2O), 0, gw, ngw, lo, hi);
}
#define TAIL_BEGIN(nunits) { const int tf_ = ((nunits) % X.G) ? ((nunits) % X.G) : 0; if (X.wg >= tf_) { const int tgw_ = (X.wg - tf_) * NWAVES + X.wave, tng_ = (X.G - tf_) * NWAVES;
#define TAIL_CONV(l_, task, lo, hi) conv_task(X, (l_), (task), (lo), (hi), tgw_, tng_);
#define TAIL_END } }
DEV void prologue_misc(const Ctx& X) {
    const size_t gt = (size_t)X.wg * NTHREADS + X.tid, GT = (size_t)X.G * NTHREADS;
    { float* rot = (float*)(X.ws + WS_ROT);
      for (size_t i = gt; i < (size_t)(SEQ + 32) * 64; i += GT) { const int p = (int)(i / 64), k = (int)(i % 64); const float pos = (float)(p < SEQ ? p : PAST + (p - SEQ));
          const float inv = powf(10000.f, -(float)k / 64.f); const float ang = pos * inv; rot[2 * i] = cosf(ang); rot[2 * i + 1] = sinf(ang); } }
    { bf16* dst = (bf16*)(X.ws + WS_LRUW);
      for (size_t i = gt; i < (size_t)DEPTH * 2 * 8 * 4096; i += GT) { const int ii = (int)(i % 64), j = (int)((i / 64) % 64), h = (int)((i / 4096) % 8), m = (int)((i / 32768) % 2), l = (int)(i / 65536);
          *(bf16*)((unsigned char*)dst + (size_t)((l * 2 + m) * 8 + h) * 8192 + frag_off(j, ii, 2)) = (bf16)f2bf((m ? INP(I_LWX) : INP(I_LWA))[(((size_t)l * 8 + h) * 64 + ii) * 64 + j]); } }
    { bf16* dst = (bf16*)(X.ws + WS_SGW);
      for (size_t i = gt; i < (size_t)DEPTH * 4 * 16384; i += GT) { const int j = (int)(i % 128), ii = (int)((i / 128) % 128); *(bf16*)((unsigned char*)dst + (i / 16384) * 32768 + frag_off(ii, j, 4)) = ((j >> 6) <= (ii >> 6)) ? (bf16)f2bf(INP(I_SGW)[i]) : (bf16)0; } }
    { bf16* xb = (bf16*)(X.ws + WS_XB);
      for (int row = X.gw; row < M; row += X.NGW) { const float* src = row < MP ? INP(I_XP) + (size_t)row * D : INP(I_XS) + (size_t)(row - MP) * D;
#pragma unroll
          for (int j = 0; j < 8; ++j) { const f32x4 v = *(const f32x4*)(src + 4 * (X.lane + 64 * j)); u32x2 o; o.x = pk2(v.x, v.y); o.y = pk2(v.z, v.w); *(u32x2*)(xb + (size_t)row * D + 4 * (X.lane + 64 * j)) = o;
              if (row < MP) { u32x2 hh; hh.x = pkh2(v.x, v.y); hh.y = pkh2(v.z, v.w); *(u32x2*)((unsigned short*)(X.ws + WS_Z) + (size_t)row * D + 4 * (X.lane + 64 * j)) = hh; } } } }
}

DEV void ln_row_finish(const Ctx& X, f32x4 (&v)[8], int row, const f32x4 (&gg)[8], const f32x4 (&bb)[8], float* xf, bool write_xb) {
    bf16* xb = (bf16*)(X.ws + WS_XB); float s = 0.f;
#pragma unroll
    for (int j = 0; j < 8; ++j) s += (v[j].x + v[j].y) + (v[j].z + v[j].w);
    const float mean = wave_sum(s) * (1.f / D); float s2 = 0.f;
#pragma unroll
    for (int j = 0; j < 8; ++j) { v[j] = v[j] - mean; s2 += (v[j].x * v[j].x + v[j].y * v[j].y) + (v[j].z * v[j].z + v[j].w * v[j].w); }
    const float rstd = rsqf_(wave_sum(s2) * (1.f / D) + LN_EPS);
    if (X.lane == 0) *(f32x2*)((float*)(X.ws + WS_STAT) + (size_t)row * 2) = (f32x2){mean, rstd};
#pragma unroll
    for (int j = 0; j < 8; ++j) { const int c = 4 * (X.lane + 64 * j);
        const f32x4 o = v[j] * rstd * gg[j] + bb[j]; if (xf) *(f32x4*)(xf + (size_t)row * D + c) = o;
        if (write_xb) { u32x2 p; p.x = pk2(o.x, o.y); p.y = pk2(o.z, o.w); *(u32x2*)(xb + (size_t)row * D + c) = p; } }
}
DEV void ln_phase(const Ctx& X, const float* Zc_, const float* g, const float* b, float* xf, bool write_xb, const float* xs_raw, const float* Zp, const float* gp, const float* bp, float scale, int nparts, bool skip_prompt = false) {
    const unsigned short* PART = (const unsigned short*)(X.ws + WS_PART); float* Zc = (float*)Zc_; const float* STAT = (const float*)(X.ws + WS_STAT);
    if (skip_prompt) {
        LAS f32x2* QS = (LAS f32x2*)X.lds; bf16* xbq = (bf16*)(X.ws + WS_XB); float* STATw = (float*)(X.ws + WS_STAT);
        for (int r2 = X.wg; r2 < MS / 2; r2 += X.G) { const int rs = 2 * r2 + (X.wave >> 2), row = MP + rs, c0 = (X.wave & 3) * 512 + 4 * X.lane; f32x4 v[2];
#pragma unroll
            for (int j = 0; j < 2; ++j) v[j] = ld4h(PART + (size_t)rs * D + c0 + 256 * j);
            for (int p = 1; p < nparts; ++p) {
#pragma unroll
                for (int j = 0; j < 2; ++j) v[j] += ld4h(PART + ((size_t)p * MS + rs) * D + c0 + 256 * j); }
            if (xs_raw) {
#pragma unroll
                for (int j = 0; j < 2; ++j) v[j] = *(const f32x4*)(xs_raw + (size_t)rs * D + c0 + 256 * j) * ALPHA + v[j] * scale; }
            else { const f32x2 st = *(const f32x2*)(STAT + (size_t)row * 2);
#pragma unroll
                for (int j = 0; j < 2; ++j) { const int c = c0 + 256 * j; const f32x4 x = (*(const f32x4*)(Zp + (size_t)row * D + c) - st.x) * st.y * *(const f32x4*)(gp + c) + *(const f32x4*)(bp + c); v[j] = x * ALPHA + v[j] * scale; } }
            float s1 = 0.f;
#pragma unroll
            for (int j = 0; j < 2; ++j) { *(f32x4*)(Zc + (size_t)row * D + c0 + 256 * j) = v[j]; s1 += (v[j].x + v[j].y) + (v[j].z + v[j].w); }
            const float mq = wave_sum(s1) * (1.f / 512.f); float s2 = 0.f;
#pragma unroll
            for (int j = 0; j < 2; ++j) { const f32x4 d = v[j] - mq; s2 += (d.x * d.x + d.y * d.y) + (d.z * d.z + d.w * d.w); }
            const float m2q = wave_sum(s2);
            if (X.lane == 0) QS[X.wave] = (f32x2){mq, m2q};
            LDS_SYNC();
            const f32x2 q0 = QS[(X.wave & 4) + 0], q1 = QS[(X.wave & 4) + 1], q2 = QS[(X.wave & 4) + 2], q3 = QS[(X.wave & 4) + 3];
            const float mean = (q0.x + q1.x + q2.x + q3.x) * 0.25f, d0 = q0.x - mean, d1 = q1.x - mean, d2 = q2.x - mean, d3 = q3.x - mean;
            const float rstd = rsqf_(((q0.y + q1.y) + (q2.y + q3.y) + 512.f * ((d0 * d0 + d1 * d1) + (d2 * d2 + d3 * d3))) * (1.f / D) + LN_EPS);
            if ((X.wave & 3) == 0 && X.lane == 0) *(f32x2*)(STATw + (size_t)row * 2) = (f32x2){mean, rstd};
#pragma unroll
            for (int j = 0; j < 2; ++j) { const int c = c0 + 256 * j; const f32x4 o = (v[j] - mean) * rstd * *(const f32x4*)(g + c) + *(const f32x4*)(b + c);
                if (xf) *(f32x4*)(xf + (size_t)row * D + c) = o;
                if (write_xb) { u32x2 pq; pq.x = pk2(o.x, o.y); pq.y = pk2(o.z, o.w); *(u32x2*)(xbq + (size_t)row * D + c) = pq; } }
            LDS_SYNC(); }
        return; }
    f32x4 gg[8], bb[8];
#pragma unroll
    for (int j = 0; j < 8; ++j) { gg[j] = *(const f32x4*)(g + 4 * (X.lane + 64 * j)); bb[j] = *(const f32x4*)(b + 4 * (X.lane + 64 * j)); }
    if (!skip_prompt) { f32x4 v[8], nx[8]; int row = X.gw;
      if (row < MP) { const f32x4* zr = (const f32x4*)(Zc + (size_t)row * D) + X.lane;
#pragma unroll
          for (int j = 0; j < 8; ++j) v[j] = zr[64 * j]; }
      while (row < MP) {
          const int nrow = row + X.NGW;
          if (nrow < MP) { const f32x4* zr = (const f32x4*)(Zc + (size_t)nrow * D) + X.lane;
#pragma unroll
              for (int j = 0; j < 8; ++j) nx[j] = zr[64 * j]; }
          ln_row_finish(X, v, row, gg, bb, xf, write_xb);
#pragma unroll
          for (int j = 0; j < 8; ++j) v[j] = nx[j];
          row = nrow; } }
    for (int r = X.gw; r < MS; r += X.NGW) { f32x4 v[8]; const int row = MP + r;
#pragma unroll
        for (int j = 0; j < 8; ++j) v[j] = ld4h(PART + (size_t)r * D + 4 * (X.lane + 64 * j));
#pragma unroll 1
        for (int p = 1; p < nparts; ++p) {
#pragma unroll
            for (int j = 0; j < 8; ++j) v[j] += ld4h(PART + ((size_t)p * MS + r) * D + 4 * (X.lane + 64 * j)); }
        if (xs_raw) {
#pragma unroll
            for (int j = 0; j < 8; ++j) v[j] = ((const f32x4*)(xs_raw + (size_t)r * D) + X.lane)[64 * j] * ALPHA + v[j] * scale; }
        else { const f32x2 st = *(const f32x2*)(STAT + (size_t)row * 2);
#pragma unroll
            for (int j = 0; j < 8; ++j) { const int c = 4 * (X.lane + 64 * j); const f32x4 x = (((const f32x4*)(Zp + (size_t)row * D) + X.lane)[64 * j] - st.x) * st.y * *(const f32x4*)(gp + c) + *(const f32x4*)(bp + c);
                v[j] = x * ALPHA + v[j] * scale; } }
#pragma unroll
        for (int j = 0; j < 8; ++j) ((f32x4*)(Zc + (size_t)row * D) + X.lane)[64 * j] = v[j];
        ln_row_finish(X, v, row, gg, bb, xf, write_xb); }
}

struct EpiSwiglu {
    static constexpr bool PERM = true, AFTER_DRAIN = false; bf16* H;
    DEV void operator()(const f32x4 (&acc)[2][2][4][2], const pg8::Unit& u, int wr, int wc, int fr, int fq) const {
#pragma unroll
        for (int ai = 0; ai < 2; ++ai)
#pragma unroll
            for (int m = 0; m < 4; ++m) { const int row = u.pm * 256 + ai * 128 + wr * 64 + m * 16 + fr; float o[8];
#pragma unroll
                for (int n = 0; n < 2; ++n)
#pragma unroll
                    for (int j = 0; j < 4; ++j) { const float gt = acc[ai][0][m][n][j], up = acc[ai][1][m][n][j]; o[4 * n + j] = siluf_(gt) * up; }
                *(u32x4*)(H + (size_t)row * FF + u.pn * 128 + wc * 32 + fq * 8) = pack8(o); }
    }
};
struct EpiResid {
    static constexpr bool PERM = true, AFTER_DRAIN = false; const float* xp; const float* zprev; const float* stat; const float* g; const float* b; float* Z; float scale;
    DEV void operator()(const f32x4 (&acc)[2][2][4][2], const pg8::Unit& u, int wr, int wc, int fr, int fq) const {
#pragma unroll
        for (int ai = 0; ai < 2; ++ai)
#pragma unroll
            for (int m = 0; m < 4; ++m) { const int row = u.pm * 256 + ai * 128 + wr * 64 + m * 16 + fr;
                const float* xr = (xp ? xp : zprev) + (size_t)row * D; f32x2 st = (f32x2){0.f, 1.f}; if (!xp) st = *(const f32x2*)(stat + (size_t)row * 2);
#pragma unroll
                for (int bj = 0; bj < 2; ++bj) { const int col = u.pn * 256 + bj * 128 + wc * 32 + fq * 8;
#pragma unroll
                    for (int n = 0; n < 2; ++n) { f32x4 xv = *(const f32x4*)(xr + col + 4 * n);
                        if (!xp) xv = (xv - st.x) * st.y * *(const f32x4*)(g + col + 4 * n) + *(const f32x4*)(b + col + 4 * n);
                        *(f32x4*)(Z + (size_t)row * D + col + 4 * n) = xv * ALPHA + acc[ai][bj][m][n] * scale; } } }
    }
};
struct PanelStats8 {
    unsigned long long* xbuf; unsigned* cnt; unsigned* tmo;
    DEV bool run(const f32x4 (&v)[2][2][4][2], const pg8::Unit& u, int wr, int wc, int fr, int fq, LAS unsigned char* lds, int wid, int lane) const {
        LAS f32x2* P = (LAS f32x2*)lds; LAS f32x2* S = (LAS f32x2*)(lds + 8192); LAS unsigned* flag = (LAS unsigned*)(lds + 8192 + 2048);
#pragma unroll
        for (int ai = 0; ai < 2; ++ai)
#pragma unroll
            for (int m = 0; m < 4; ++m) { float s = 0.f;
#pragma unroll
                for (int bj = 0; bj < 2; ++bj)
#pragma unroll
                    for (int n = 0; n < 2; ++n) { const f32x4 x = v[ai][bj][m][n]; s += (x[0] + x[1]) + (x[2] + x[3]); }
                s += SHFL_XOR(s, 16); s += SHFL_XOR(s, 32);
                const float mw = s * (1.0f / 64.0f); float q = 0.f;
#pragma unroll
                for (int bj = 0; bj < 2; ++bj)
#pragma unroll
                    for (int n = 0; n < 2; ++n) { const f32x4 d = v[ai][bj][m][n] - mw; q += (d[0] * d[0] + d[1] * d[1]) + (d[2] * d[2] + d[3] * d[3]); }
                q += SHFL_XOR(q, 16); q += SHFL_XOR(q, 32);
                if (fq == 0) P[(ai * 128 + wr * 64 + m * 16 + fr) * 4 + wc] = (f32x2){mw, q}; }
        LDS_SYNC();
        const int row = wid * 32 + (lane & 31);
        if (lane < 32) { const f32x2 a = P[row * 4 + 0], b = P[row * 4 + 1], c = P[row * 4 + 2], d = P[row * 4 + 3];
            const float mt = (a.x + b.x + c.x + d.x) * 0.25f; const float da = a.x - mt, db = b.x - mt, dc = c.x - mt, dd = d.x - mt;
            const float m2 = (a.y + b.y) + (c.y + d.y) + 64.0f * ((da * da + db * db) + (dc * dc + dd * dd));
            __hip_atomic_store(xbuf + ((size_t)(u.pm * 256 + row) * 8 + u.pn), ((unsigned long long)__builtin_bit_cast(unsigned, m2) << 32) | __builtin_bit_cast(unsigned, mt), __ATOMIC_RELAXED, __HIP_MEMORY_SCOPE_AGENT); }
        WAVE_LDS_SYNC();
        WAIT_VM(0);
        if (lane == 0) __hip_atomic_fetch_add(cnt + 64 * u.pm, 1u, __ATOMIC_RELAXED, __HIP_MEMORY_SCOPE_AGENT);
        if (wid == 0) { bool dead = false; unsigned spins = 0;
            for (;;) { if ((unsigned)__builtin_amdgcn_readfirstlane(__hip_atomic_load(cnt + 64 * u.pm, __ATOMIC_RELAXED, __HIP_MEMORY_SCOPE_AGENT)) >= 64u) break;
                if (++spins > (1u << 20)) { if (lane == 0) __hip_atomic_store(tmo, 1u, __ATOMIC_RELAXED, __HIP_MEMORY_SCOPE_AGENT); dead = true; break; }
                __builtin_amdgcn_s_sleep(2); }
            __builtin_amdgcn_fence(__ATOMIC_ACQUIRE, "agent");
            if (lane == 0) flag[0] = dead ? 1u : 0u; }
        WAIT_VM(0); LDS_SYNC();
        const bool bad = flag[0] != 0u;
        if (lane < 32) { const unsigned long long* slot = xbuf + (size_t)(u.pm * 256 + row) * 8; float mt[8], m2[8]; float ms = 0.f;
#pragma unroll
            for (int t = 0; t < 8; ++t) { const unsigned long long w = __hip_atomic_load(slot + t, __ATOMIC_RELAXED, __HIP_MEMORY_SCOPE_AGENT); mt[t] = __builtin_bit_cast(float, (unsigned)w); m2[t] = __builtin_bit_cast(float, (unsigned)(w >> 32)); ms += mt[t]; }
            const float mean = ms * 0.125f; float q = 0.f;
#pragma unroll
            for (int t = 0; t < 8; ++t) { const float dm = mt[t] - mean; q += m2[t] + 256.0f * dm * dm; }
            S[row] = (f32x2){mean, rsqf_(q * (1.0f / 2048.0f) + LN_EPS)}; }
        LDS_SYNC();
        return bad;
    }
};
struct EpiResidLn {
    static constexpr bool PERM = true, AFTER_DRAIN = true;
    unsigned char* ws; float* out; int raw, zprev_odd, k, l; float scale;
    DEV void operator()(const f32x4 (&)[2][2][4][2], const pg8::Unit&, int, int, int, int) const {}
    DEV void fused(f32x4 (&acc)[2][2][4][2], const pg8::Unit& u, int wr, int wc, int fr, int fq, LAS unsigned char* lds, int wid, int lane) const {
        const float* g = k == 0 ? INP(I_LN1G) + l * D : (k == 1 ? INP(I_LN2G) + l * D : INP(I_LN3G) + l * D); const float* b = k == 0 ? INP(I_LN1B) + l * D : (k == 1 ? INP(I_LN2B) + l * D : INP(I_LN3B) + l * D);
        const bool fin = (k == 2 && l == DEPTH - 1); float* xf = fin ? out : nullptr; bf16* xb = fin ? nullptr : (bf16*)(ws + WS_XB); unsigned short* xh = (unsigned short*)(ws + WS_Z);
        const PanelStats8 ps{(unsigned long long*)(ws + WS_XSLOT), (unsigned*)(ws + WS_CTL) + CW_PANEL + (3 * l + k) * 2048, (unsigned*)(ws + WS_CTL) + CW_TMO};
#pragma unroll
        for (int ai = 0; ai < 2; ++ai)
#pragma unroll
            for (int m = 0; m < 4; ++m) { const int row = u.pm * 256 + ai * 128 + wr * 64 + m * 16 + fr;
#pragma unroll
                for (int bj = 0; bj < 2; ++bj) { const int col = u.pn * 256 + bj * 128 + wc * 32 + fq * 8; float x8[8];
                    unpack8h(*(const u32x4*)(xh + (size_t)row * D + col), x8);
#pragma unroll
                    for (int n = 0; n < 2; ++n) acc[ai][bj][m][n] = (f32x4){x8[4 * n], x8[4 * n + 1], x8[4 * n + 2], x8[4 * n + 3]} * ALPHA + acc[ai][bj][m][n] * scale; } }
        f32x4 g4[2][2], b4[2][2];
#pragma unroll
        for (int bj = 0; bj < 2; ++bj)
#pragma unroll
            for (int n = 0; n < 2; ++n) { const int col = u.pn * 256 + bj * 128 + wc * 32 + fq * 8 + 4 * n; g4[bj][n] = *(const f32x4*)(g + col); b4[bj][n] = *(const f32x4*)(b + col); }
        const bool bad = ps.run(acc, u, wr, wc, fr, fq, lds, wid, lane);
        const LAS f32x2* S = (const LAS f32x2*)(lds + 8192); const float qnan = __builtin_nanf("");
#pragma unroll
        for (int ai = 0; ai < 2; ++ai)
#pragma unroll
            for (int m = 0; m < 4; ++m) { const int r = ai * 128 + wr * 64 + m * 16 + fr, row = u.pm * 256 + r; f32x2 sr = S[r]; if (bad) sr = (f32x2){qnan, qnan};
#pragma unroll
                for (int bj = 0; bj < 2; ++bj) { const int col = u.pn * 256 + bj * 128 + wc * 32 + fq * 8; float o[8];
#pragma unroll
                    for (int n = 0; n < 2; ++n) { const f32x4 x = (acc[ai][bj][m][n] - sr.x) * sr.y * g4[bj][n] + b4[bj][n]; o[4 * n] = x[0]; o[4 * n + 1] = x[1]; o[4 * n + 2] = x[2]; o[4 * n + 3] = x[3];
                        if (xf) *(f32x4*)(xf + (size_t)row * D + col + 4 * n) = x; }
                    if (xb) { *(u32x4*)(xb + (size_t)row * D + col) = pack8(o); *(u32x4*)(xh + (size_t)row * D + col) = pack8h(o); } } }
        LDS_SYNC();
    }
};
constexpr int KS_FF = (FF % 512 == 0) ? 512 : FF, KS_D = 256;
struct EpiPart {
    static constexpr bool PERM = true, AFTER_DRAIN = false; float* part; int klen;
    DEV void operator()(const f32x4 (&acc)[2][2][4][2], const pg8::Unit& u, int wr, int wc, int fr, int fq) const {
        unsigned short* base = (unsigned short*)part + (size_t)(u.k0 / klen) * MS * D;
#pragma unroll
        for (int ai = 0; ai < 2; ++ai)
#pragma unroll
            for (int m = 0; m < 4; ++m) { const int row = u.pm * 256 + ai * 128 + wr * 64 + m * 16 + fr - MP;
#pragma unroll
                for (int bj = 0; bj < 2; ++bj) { const int col = u.pn * 256 + bj * 128 + wc * 32 + fq * 8; float o[8];
#pragma unroll
                    for (int n = 0; n < 2; ++n) { const f32x4 a = acc[ai][bj][m][n]; o[4 * n] = a[0]; o[4 * n + 1] = a[1]; o[4 * n + 2] = a[2]; o[4 * n + 3] = a[3]; }
                    *(u32x4*)(base + (size_t)row * D + col) = pack8h(o); } }
    }
};
struct EpiProj {
    static constexpr bool PERM = true, AFTER_DRAIN = false; bf16* P; float* gab;
    DEV void operator()(const f32x4 (&acc)[2][2][4][2], const pg8::Unit& u, int wr, int wc, int fr, int fq) const {
#pragma unroll
        for (int ai = 0; ai < 2; ++ai)
#pragma unroll
            for (int m = 0; m < 4; ++m) { const int row = u.pm * 256 + ai * 128 + wr * 64 + m * 16 + fr;
                if (u.pn < NPROJ / 256) {
#pragma unroll
                    for (int bj = 0; bj < 2; ++bj) { float o[8];
#pragma unroll
                        for (int n = 0; n < 2; ++n)
#pragma unroll
                            for (int j = 0; j < 4; ++j) o[4 * n + j] = acc[ai][bj][m][n][j];
                        *(u32x4*)(P + (size_t)row * NPROJ + u.pn * 256 + bj * 128 + wc * 32 + fq * 8) = pack8(o); }
                } else if (wc == 0 && fq == 0) { *(f32x4*)(gab + (size_t)row * 8) = acc[ai][0][m][0]; *(f32x4*)(gab + (size_t)row * 8 + 4) = acc[ai][0][m][1]; } }
    }
};

constexpr int LD136 = 272, LD72 = 144;
DEV float ret_log_g(int h) { return log1pf(-exp2f(-5.f - (float)h)); }
DEV void rot_piece(const bf16* src_row_head, const float* rotrow, int d, float scale, LAS unsigned char* T, int j) {
    float x1[8], x2[8], o1[8], o2[8]; unpack8(*(const u32x4*)(src_row_head + d), x1); unpack8(*(const u32x4*)(src_row_head + 64 + d), x2);
#pragma unroll
    for (int i = 0; i < 8; ++i) { const f32x2 cs = *(const f32x2*)(rotrow + 2 * (d + i)); o1[i] = (x1[i] * cs.x - x2[i] * cs.y) * scale; o2[i] = (x1[i] * cs.y + x2[i] * cs.x) * scale; }
    *(LAS u32x4*)(T + j * LD136 + d * 2) = pack8(o1); *(LAS u32x4*)(T + j * LD136 + (64 + d) * 2) = pack8(o2);
}
DEV void ret_u_unit(const Ctx& X, int ck, int h) {
    const Chunk c = chunk_of(ck); const bf16* P = (const bf16*)(X.ws + WS_HP); const float* rot = (const float*)(X.ws + WS_ROT);
    LAS unsigned char* Kd = X.lds; LAS unsigned char* Vs = X.lds + 17408; const float lg = ret_log_g(h);
    for (int idx = X.tid; idx < c.C * 8; idx += NTHREADS) { const int j = idx >> 3, d = (idx & 7) * 8;
        rot_piece(P + (size_t)(c.row0 + j) * NPROJ + 512 + h * 128, rot + (size_t)(c.rot0 + j) * 128, d, 0.08838834764831845f * __expf(lg * (float)(c.C - 1 - j)), Kd, j); }
    for (int idx = X.tid; idx < c.C * 16; idx += NTHREADS) { const int j = idx >> 4, o = (idx & 15) * 8;
        *(LAS u32x4*)(Vs + j * LD136 + o * 2) = *(const u32x4*)(P + (size_t)(c.row0 + j) * NPROJ + 1024 + h * 128 + o); }
    LDS_SYNC();
    f32x4 acc[8];
#pragma unroll
    for (int t = 0; t < 8; ++t) acc[t] = (f32x4){0.f, 0.f, 0.f, 0.f};
    for (int ks = 0; ks < c.C / 32; ++ks) { const bf16x8 a = lds_trfrag(Kd, LD136, 32 * ks, 16 * X.wave, X.lane);
#pragma unroll
        for (int t = 0; t < 8; ++t) acc[t] = mfma16(a, lds_trfrag(Vs, LD136, 32 * ks, 16 * t, X.lane), acc[t]); }
    unsigned short* U = (unsigned short*)(X.ws + WS_U) + (size_t)(ck * 4 + h) * 16384;
#pragma unroll
    for (int t = 0; t < 8; ++t)
#pragma unroll
        for (int r = 0; r < 4; ++r) U[(16 * X.wave + 4 * (X.lane >> 4) + r) * 128 + 16 * t + (X.lane & 15)] = f2h(acc[t][r]);
    LDS_SYNC();
}
template <class WP> DEV void conv16(const Ctx& X, const Chunk& c, int l, int t, int pcol, const float* state, int swidth, int scol, WP cw, int cws, float (&y)[16]) {
    const bf16* P = (const bf16*)(X.ws + WS_HP);
#pragma unroll
    for (int i = 0; i < 16; ++i) y[i] = 0.f;
#pragma unroll
    for (int j = 0; j < 4; ++j) { const int tt = t - 3 + j; float xr[16];
        if (tt >= 0 || (!c.sample && c.n > 0)) { const bf16* src = P + (size_t)(c.row0 + tt) * NPROJ + pcol; unpack8(*(const u32x4*)src, xr); unpack8(*(const u32x4*)(src + 8), xr + 8); }
        else if (c.sample) { const f32x4* s = (const f32x4*)(state + ((size_t)(l * DB + c.stream) * 3 + (3 + tt)) * swidth + scol);
#pragma unroll
            for (int i = 0; i < 4; ++i) { const f32x4 v = s[i]; xr[4 * i] = v.x; xr[4 * i + 1] = v.y; xr[4 * i + 2] = v.z; xr[4 * i + 3] = v.w; } }
        else {
#pragma unroll
            for (int i = 0; i < 16; ++i) xr[i] = 0.f; }
#pragma unroll
        for (int i = 0; i < 4; ++i) { const f32x4 w = (f32x4){cw[j * cws + 4 * i], cw[j * cws + 4 * i + 1], cw[j * cws + 4 * i + 2], cw[j * cws + 4 * i + 3]}; y[4 * i] += w.x * xr[4 * i]; y[4 * i + 1] += w.y * xr[4 * i + 1]; y[4 * i + 2] += w.z * xr[4 * i + 2]; y[4 * i + 3] += w.w * xr[4 * i + 3]; } }
}
DEV void dn_prep_unit_a(const Ctx& X, int l, int ck, int h) {
    const Chunk c = chunk_of(ck); const int unit = ck * 4 + h; const float* gab = (const float*)(X.ws + WS_GAB);
    LAS float* RHS = (LAS float*)X.lds; LAS unsigned char* Qs = X.lds + 66560; LAS unsigned char* Ks = X.lds + 83968; LAS unsigned char* XT = X.lds + 66560;
    LAS unsigned char* Aoff = X.lds + 103424; LAS float* Adiag = (LAS float*)(X.lds + 112640); LAS unsigned char* DI = X.lds + 116736; LAS unsigned char* TT = X.lds + 121856;
    LAS float* sG = (LAS float*)(X.lds + 142336); LAS float* sB = sG + 64; LAS float* sGC = sG + 128;
    LAS float* CWL = (LAS float*)TT;
    if (X.tid < 384) { const int mm = X.tid >> 7, j = (X.tid >> 5) & 3, q4 = X.tid & 31; *(LAS f32x4*)(CWL + (mm * 4 + j) * 128 + 4 * q4) = *(const f32x4*)(INP(I_DCW) + (size_t)l * 4 * 1536 + j * 1536 + mm * 512 + h * 128 + 4 * q4); }
    if (X.tid < c.C) { const int row = c.row0 + X.tid;
        sG[X.tid] = -__expf(INP(I_DALOG)[l * 4 + h]) * softplusf_(gab[(size_t)row * 8 + h] + INP(I_DDT)[l * 4 + h]); sB[X.tid] = sigmoidf_(gab[(size_t)row * 8 + 4 + h]); }
    LDS_SYNC();
    if (X.wave == 0) { float sc = X.lane < c.C ? sG[X.lane] : 0.f;
#pragma unroll
        for (int d = 1; d < 64; d <<= 1) { const float o = SHFL_UP(sc, d); if (X.lane >= d) sc += o; }
        if (X.lane < c.C) sGC[X.lane] = sc; }
    LDS_SYNC();
    { const int t0 = X.tid >> 3, part = X.tid & 7, t = t0 < c.C ? t0 : c.C - 1; const bool valid = t0 < c.C; const int row = c.row0 + t;
      const float beta = sB[t], gc = sGC[t], gl = sGC[c.C - 1], egc = __expf(gc), ekd = __expf(gl - gc);
#pragma unroll
      for (int mm = 0; mm < 3; ++mm) {
          const int cc = mm * 512 + h * 128 + 16 * part; float y[16];
          conv16(X, c, l, t, 4096 + cc, INP(I_SDC), 1536, cc, (const LAS float*)(CWL + mm * 512 + 16 * part), 128, y);
#pragma unroll
          for (int i = 0; i < 16; ++i) y[i] = siluf_(y[i]);
          if (mm < 2) { float ss = 0.f;
#pragma unroll
              for (int i = 0; i < 16; ++i) ss += y[i] * y[i];
              ss += SHFL_XOR(ss, 1); ss += SHFL_XOR(ss, 2); ss += SHFL_XOR(ss, 4);
              const float rn = (mm == 0 ? 0.08838834764831845f : 1.f) * rsqf_(ss + 1e-6f);
#pragma unroll
              for (int i = 0; i < 16; ++i) y[i] *= rn; }
          if (valid) {
              if (mm == 0) { float qd[16];
#pragma unroll
                  for (int i = 0; i < 16; ++i) qd[i] = y[i] * egc;
                  *(LAS u32x4*)(Qs + t * LD136 + part * 32) = pack8(y); *(LAS u32x4*)(Qs + t * LD136 + part * 32 + 16) = pack8(y + 8);
                  unsigned char* dq = X.ws + WS_DNQ + (size_t)unit * 16384; *(u32x4*)(dq + frag_off(t, 16 * part, 4)) = pack8(qd); *(u32x4*)(dq + frag_off(t, 16 * part + 8, 4)) = pack8(qd + 8); }
              else if (mm == 1) {
                  *(LAS u32x4*)(Ks + t * LD136 + part * 32) = pack8(y); *(LAS u32x4*)(Ks + t * LD136 + part * 32 + 16) = pack8(y + 8);
                  unsigned char* dk = X.ws + WS_DNK + (size_t)unit * 16384 + frag_off(16 * part, t, 2);
#pragma unroll
                  for (int i = 0; i < 16; ++i) *(bf16*)(dk + i * 16) = (bf16)f2bf(y[i] * ekd);
                  const float bk = beta * egc;
#pragma unroll
                  for (int i = 0; i < 4; ++i) *(LAS f32x4*)(RHS + t * 260 + 128 + 16 * part + 4 * i) = (f32x4){bk * y[4 * i], bk * y[4 * i + 1], bk * y[4 * i + 2], bk * y[4 * i + 3]}; }
              else {
#pragma unroll
                  for (int i = 0; i < 4; ++i) *(LAS f32x4*)(RHS + t * 260 + 16 * part + 4 * i) = (f32x4){beta * y[4 * i], beta * y[4 * i + 1], beta * y[4 * i + 2], beta * y[4 * i + 3]}; } } }
      if (X.tid == 0) ((float*)(X.ws + WS_DNGL))[unit] = gl; }
    LDS_SYNC();
}
DEV void dn_prep_unit_b(const Ctx& X, int l, int ck, int h) {
    const Chunk c = chunk_of(ck); const int unit = ck * 4 + h;
    LAS float* RHS = (LAS float*)X.lds; LAS unsigned char* Qs = X.lds + 66560; LAS unsigned char* Ks = X.lds + 83968; LAS unsigned char* XT = X.lds + 66560;
    LAS unsigned char* Aoff = X.lds + 103424; LAS float* Adiag = (LAS float*)(X.lds + 112640); LAS unsigned char* DI = X.lds + 116736; LAS unsigned char* TT = X.lds + 121856;
    LAS float* sG = (LAS float*)(X.lds + 142336); LAS float* sB = sG + 64; LAS float* sGC = sG + 128;
    { const int nt = c.C / 16; unsigned char* attn = X.ws + WS_DNA + (size_t)unit * 8192;
      for (int tt = X.wave; tt < 2 * nt * nt; tt += NWAVES) { const int which = tt / (nt * nt), it = (tt % (nt * nt)) / nt, jt = tt % nt;
          f32x4 acc = (f32x4){0.f, 0.f, 0.f, 0.f};
          if (jt <= it) {
#pragma unroll
              for (int ks = 0; ks < 4; ++ks) acc = mfma16(lds_rowfrag(which ? Qs : Ks, LD136, 16 * it, 32 * ks, X.lane), lds_rowfrag(Ks, LD136, 16 * jt, 32 * ks, X.lane), acc); }
          const int j = 16 * jt + (X.lane & 15); const float gcj = sGC[j];
#pragma unroll
          for (int r = 0; r < 4; ++r) { const int i = 16 * it + 4 * (X.lane >> 4) + r; const float dec = __expf(fminf(sGC[i] - gcj, 0.f));
              if (which == 0) { const float a = (j < i) ? sB[i] * acc[r] * dec : 0.f;
                  if (it == jt) Adiag[(it * 16 + (i & 15)) * 16 + (j & 15)] = a;
                  *(LAS bf16*)(Aoff + i * LD72 + j * 2) = (bf16)((it == jt) ? 0u : f2bf(a)); }
              else *(bf16*)(attn + frag_off(i, j, 2)) = (bf16)((j <= i) ? f2bf(acc[r] * dec) : 0u); } } }
    LDS_SYNC();
    { const int nb = c.C / 16, lane = X.lane, g = lane >> 4, lc = lane & 15, w = X.wave;
      for (int i = X.tid; i < 36864 / 16; i += NTHREADS) *(LAS u32x4*)(XT + i * 16) = (u32x4){0u, 0u, 0u, 0u};
      for (int i = X.tid; i < 20480 / 16; i += NTHREADS) *(LAS u32x4*)(TT + i * 16) = (u32x4){0u, 0u, 0u, 0u};
      if (w == 0 && g < nb) { float x[16];
#pragma unroll
          for (int i = 0; i < 16; ++i) { float a = (i == lc) ? 1.f : 0.f;
#pragma unroll
              for (int j = 0; j < i; ++j) a -= Adiag[(g * 16 + i) * 16 + j] * x[j];
              x[i] = a; }
#pragma unroll
          for (int i = 0; i < 16; ++i) *(LAS bf16*)(DI + (g * 16 + i) * 80 + lc * 2) = (bf16)f2bf(x[i]);
          *(LAS u32x4*)(DI + (g * 16 + lc) * 80 + 32) = (u32x4){0u, 0u, 0u, 0u}; *(LAS u32x4*)(DI + (g * 16 + lc) * 80 + 48) = (u32x4){0u, 0u, 0u, 0u}; }
      LDS_SYNC();
      LAS unsigned char* TTw = TT + w * 2560;
      for (int b = 0; b < nb; ++b) { const int nks = (16 * b + 31) / 32;
#pragma unroll
          for (int tt = 0; tt < 2; ++tt) { const int ct = w + 8 * tt; f32x4 acc = (f32x4){0.f, 0.f, 0.f, 0.f};
              for (int ks = 0; ks < nks; ++ks) acc = mfma16(lds_rowfrag(Aoff, LD72, 16 * b, 32 * ks, lane), lds_rowfrag(XT, LD72, 16 * ct, 32 * ks, lane), acc);
              float t4[4];
#pragma unroll
              for (int r = 0; r < 4; ++r) t4[r] = RHS[(16 * b + 4 * g + r) * 260 + 16 * ct + lc] - acc[r];
              u32x2 p; p.x = pk2(t4[0], t4[1]); p.y = pk2(t4[2], t4[3]); *(LAS u32x2*)(TTw + (16 * tt + lc) * 80 + 8 * g) = p; }
          WAVE_LDS_SYNC();
#pragma unroll
          for (int tt = 0; tt < 2; ++tt) { const int ct = w + 8 * tt, cc = 16 * ct + lc;
              const f32x4 xv = mfma16(lds_rowfrag(DI + b * 1280, 80, 0, 0, lane), lds_rowfrag(TTw, 80, 16 * tt, 0, lane), (f32x4){0.f, 0.f, 0.f, 0.f});
              u32x2 p; p.x = pk2(xv[0], xv[1]); p.y = pk2(xv[2], xv[3]); *(LAS u32x2*)(XT + cc * LD72 + (16 * b + 4 * g) * 2) = p;
              if (cc < 128) { bf16* dst = (bf16*)(X.ws + WS_DNU) + (size_t)(c.row0 + 16 * b + 4 * g) * 512 + h * 128 + cc;
#pragma unroll
                  for (int r = 0; r < 4; ++r) dst[(size_t)r * 512] = (bf16)f2bf(xv[r]); }
              else { unsigned char* dst = X.ws + WS_DNW + (size_t)unit * 16384 + frag_off(16 * b + 4 * g, cc - 128, 4);
#pragma unroll
                  for (int r = 0; r < 4; ++r) *(bf16*)(dst + r * 16) = (bf16)f2bf(xv[r]); } }
          WAVE_LDS_SYNC(); } }
    LDS_SYNC();
}
DEV void lru_prep_unit(const Ctx& X, int l, int ck, int q4) {
    const Chunk c = chunk_of(ck); const int c0 = q4 * 128;
    LAS float* XC = (LAS float*)X.lds; LAS unsigned char* XCb = X.lds + 33792; LAS float* AA = (LAS float*)(X.lds + 51200);
    { const int t0 = X.tid >> 3, part = X.tid & 7; if (t0 < c.C) { const int t = t0, cc = c0 + 16 * part; float y[16]; conv16(X, c, l, t, 2560 + cc, INP(I_SLC), 512, cc, INP(I_LCW) + (size_t)l * 4 * 512 + cc, 512, y);
          const float* cb = INP(I_LCB) + (size_t)l * 512;
#pragma unroll
          for (int i = 0; i < 16; ++i) { y[i] += cb[cc + i]; XC[t * 132 + 16 * part + i] = y[i]; }
          *(LAS u32x4*)(XCb + t * LD136 + part * 32) = pack8(y); *(LAS u32x4*)(XCb + t * LD136 + part * 32 + 16) = pack8(y + 8); } }
    LDS_SYNC();
    { const bf16* WT = (const bf16*)(X.ws + WS_LRUW) + (size_t)l * 2 * 8 * 4096; const int ct = X.wave, hb = 2 * q4 + (ct >> 2), j0 = 16 * (ct & 3);
      const int cl = 16 * ct + (X.lane & 15), cg = c0 + cl;
      const float ba = INP(I_LBA)[l * 512 + cg], bx = INP(I_LBX)[l * 512 + cg], spl = softplusf_(-INP(I_LAM)[l * 512 + cg]);
      for (int rt = 0; rt < c.C / 16; ++rt) { f32x4 aR = (f32x4){0.f, 0.f, 0.f, 0.f}, aI = aR;
#pragma unroll
          for (int ks = 0; ks < 2; ++ks) { const bf16x8 a = lds_rowfrag(XCb, LD136, 16 * rt, (ct >> 2) * 64 + 32 * ks, X.lane);
              aR = mfma16(a, glb_frag(WT + (size_t)hb * 4096, 2, j0 >> 4, ks, X.lane), aR); aI = mfma16(a, glb_frag(WT + (size_t)(8 + hb) * 4096, 2, j0 >> 4, ks, X.lane), aI); }
#pragma unroll
          for (int r = 0; r < 4; ++r) { const int t = 16 * rt + 4 * (X.lane >> 4) + r; const float rr = sigmoidf_(aR[r] + ba), ii = sigmoidf_(aI[r] + bx);
              const float la = -8.f * rr * spl, a = __expf(la), bb = sqrf_(fmaxf(1.f - a * a, 0.f)) * (ii * XC[t * 132 + cl]);        AA[t * 132 + cl] = a; XC[t * 132 + cl] = bb; } } }
    LDS_SYNC();
    if (X.tid < 128) { const int cl = X.tid; float hl = 0.f, ac = 1.f; unsigned short* LRH = (unsigned short*)(X.ws + WS_LRH); unsigned short* LRA = (unsigned short*)(X.ws + WS_LRA);
        for (int t0 = 0; t0 < c.C; t0 += 8) { float a8[8], b8[8];
#pragma unroll
            for (int k = 0; k < 8; ++k) { a8[k] = AA[(t0 + k) * 132 + cl]; b8[k] = XC[(t0 + k) * 132 + cl]; }
#pragma unroll
            for (int k = 0; k < 8; ++k) { hl = a8[k] * hl + b8[k]; ac *= a8[k]; LRH[(size_t)(c.row0 + t0 + k) * 512 + c0 + cl] = f2h(hl); LRA[(size_t)(c.row0 + t0 + k) * 512 + c0 + cl] = f2h(ac); } } }
    else if (X.tid < 512 && (c.sample || c.n == NCH - 1)) {
        const int e = X.tid - 128, tt = e >> 7, cl = e & 127; const bf16* P = (const bf16*)(X.ws + WS_HP);
        const float v = bf2f(P[(size_t)(c.row0 + c.C - 3 + tt) * NPROJ + 2560 + c0 + cl]);
        float* o = X.out + (c.sample ? O_LCS + ((size_t)(l * DB + c.stream) * 3 + tt) * 512 : O_LCP + ((size_t)(l * BATCH + c.stream) * 3 + tt) * 512) + c0 + cl; *o = v; }
    LDS_SYNC();
}
DEV void sg_ln_rows(const Ctx& X, int l) {
    const bf16* P = (const bf16*)(X.ws + WS_HP); bf16* VN = (bf16*)(X.ws + WS_VN); const float* g = INP(I_SGG) + l * 512; const float* b = INP(I_SGB) + l * 512;
    for (int row = X.gw; row < M; row += X.NGW) { float v[8]; unpack8(*(const u32x4*)(P + (size_t)row * NPROJ + 3584 + 8 * X.lane), v); float s = 0.f;
#pragma unroll
        for (int i = 0; i < 8; ++i) { v[i] = geluf_(v[i]); s += v[i]; }
        const float mean = wave_sum(s) * (1.f / 512.f); float s2 = 0.f;
#pragma unroll
        for (int i = 0; i < 8; ++i) { v[i] -= mean; s2 += v[i] * v[i]; }
        const float rstd = rsqf_(wave_sum(s2) * (1.f / 512.f) + LN_EPS);
#pragma unroll
        for (int i = 0; i < 8; ++i) v[i] = v[i] * rstd * g[8 * X.lane + i] + b[8 * X.lane + i];
        *(u32x4*)(VN + (size_t)row * 512 + 8 * X.lane) = pack8(v);
        if (row >= MP) { float* o = X.out + O_SGV + ((size_t)l * MS + (row - MP)) * 512 + 8 * X.lane; *(f32x4*)o = (f32x4){v[0], v[1], v[2], v[3]}; *(f32x4*)(o + 4) = (f32x4){v[4], v[5], v[6], v[7]}; } }
}

DEV void dn_seq_unit(const Ctx& X, int l, bool sample, int stream, int h, int s4) {
    LAS unsigned char* ST = X.lds; LAS unsigned char* VT = X.lds + 8704;
    const int w = X.wave, lane = X.lane, g = lane >> 4, lc = lane & 15, it = w & 3, et = w >> 2;
    const int C = sample ? 32 : 64, nsteps = sample ? 1 : NCH; const bool v12 = it < C / 16;
    f32x4 S[2];
    if (sample) { const float* s0 = INP(I_SDN) + ((size_t)(l * DB + stream) * 4 + h) * 16384;
#pragma unroll
        for (int t = 0; t < 2; ++t)
#pragma unroll
            for (int r = 0; r < 4; ++r) S[t][r] = s0[(16 * w + 4 * g + r) * 128 + 32 * s4 + 16 * t + lc]; }
    else { S[0] = (f32x4){0.f, 0.f, 0.f, 0.f}; S[1] = S[0]; }
    const bf16* DNU = (const bf16*)(X.ws + WS_DNU); const bf16* DNW = (const bf16*)(X.ws + WS_DNW); const bf16* DNQ = (const bf16*)(X.ws + WS_DNQ);
    const bf16* DNK = (const bf16*)(X.ws + WS_DNK); const bf16* DNA = (const bf16*)(X.ws + WS_DNA); const float* DNGL = (const float*)(X.ws + WS_DNGL); unsigned short* DNO = (unsigned short*)(X.ws + WS_DNO);
    struct Ops { bf16x8 wf[4], qf[4], af[2], kf[2]; unsigned uu[4]; float gl; };
    const int ri = v12 ? 16 * it : 0;
#define DN_LOAD(O, n_) do { const int ck_ = sample ? NPCH + stream : stream * NCH + (n_), unit_ = ck_ * 4 + h, row0_ = sample ? MP + 32 * stream : ck_ * 64; \
        _Pragma("unroll") for (int ks = 0; ks < 4; ++ks) { (O).wf[ks] = glb_frag(DNW + (size_t)unit_ * 8192, 4, ri >> 4, ks, lane); (O).qf[ks] = glb_frag(DNQ + (size_t)unit_ * 8192, 4, ri >> 4, ks, lane); } \
        _Pragma("unroll") for (int ks = 0; ks < 2; ++ks) { const int kk = (ks < C / 32) ? ks : 0; (O).af[ks] = glb_frag(DNA + (size_t)unit_ * 4096, 2, ri >> 4, kk, lane); (O).kf[ks] = glb_frag(DNK + (size_t)unit_ * 8192, 2, w, kk, lane); } \
        _Pragma("unroll") for (int r = 0; r < 4; ++r) (O).uu[r] = *(const unsigned*)(DNU + (size_t)(row0_ + ri + 4 * g + r) * 512 + h * 128 + 32 * s4 + 16 * et + (lc & ~1));   \
        (O).gl = DNGL[unit_]; } while (0)
    Ops opA, opB, opC; DN_LOAD(opA, 0); if (!sample) DN_LOAD(opB, 1);
#define DN_STEP(cur, pf, n_) do { const int n = (n_); __builtin_amdgcn_sched_barrier(0);        \
        const int ck = sample ? NPCH + stream : stream * NCH + n, row0 = sample ? MP + 32 * stream : ck * 64; \
        LAS unsigned char* STp = ST + (n & 1) * 13312; LAS unsigned char* VTp = VT + (n & 1) * 13312;        \
        _Pragma("unroll") for (int t = 0; t < 2; ++t) { u32x2 p; p.x = pk2(S[t][0], S[t][1]); p.y = pk2(S[t][2], S[t][3]); *(LAS u32x2*)(STp + (16 * t + lc) * LD136 + (16 * w + 4 * g) * 2) = p; } \
        const float eg = __expf((cur).gl); \
        LDS_SYNC(); \
        f32x4 vn = (f32x4){0.f, 0.f, 0.f, 0.f}, o = (f32x4){0.f, 0.f, 0.f, 0.f}; \
        if (v12) { \
            _Pragma("unroll") for (int ks = 0; ks < 4; ++ks) { const bf16x8 bs = lds_rowfrag(STp, LD136, 16 * et, 32 * ks, lane); vn = mfma16((cur).wf[ks], bs, vn); o = mfma16((cur).qf[ks], bs, o); } \
            _Pragma("unroll") for (int r = 0; r < 4; ++r) vn[r] = ((lc & 1) ? bfhi((cur).uu[r]) : bflo((cur).uu[r])) - vn[r]; \
            u32x2 p; p.x = pk2(vn[0], vn[1]); p.y = pk2(vn[2], vn[3]); *(LAS u32x2*)(VTp + (16 * et + lc) * LD72 + (16 * it + 4 * g) * 2) = p; } \
        LDS_SYNC(); \
        if (!sample) { const int np_ = n + 2 < nsteps ? n + 2 : nsteps - 1; DN_LOAD(pf, np_); } \
        if (v12) { \
            for (int ks = 0; ks < C / 32; ++ks) o = mfma16((cur).af[ks], lds_rowfrag(VTp, LD72, 16 * et, 32 * ks, lane), o); \
            _Pragma("unroll") for (int r = 0; r < 4; ++r) DNO[(size_t)(row0 + 16 * it + 4 * g + r) * 512 + h * 128 + 32 * s4 + 16 * et + lc] = f2h(o[r]); } \
        _Pragma("unroll") for (int t = 0; t < 2; ++t) { S[t] = S[t] * eg; for (int ks = 0; ks < C / 32; ++ks) S[t] = mfma16((cur).kf[ks], lds_rowfrag(VTp, LD72, 16 * t, 32 * ks, lane), S[t]); } \
        } while (0)
    int n3 = 0;
    for (; n3 + 2 < nsteps; n3 += 3) { DN_STEP(opA, opC, n3); DN_STEP(opB, opA, n3 + 1); DN_STEP(opC, opB, n3 + 2); }
    if (n3 < nsteps) { DN_STEP(opA, opC, n3); if (n3 + 1 < nsteps) DN_STEP(opB, opA, n3 + 1); }
#undef DN_STEP
    LDS_SYNC();
#undef DN_LOAD
    float* so = X.out + (sample ? O_DNS + ((size_t)(l * DB + stream) * 4 + h) * 16384 : O_DNP + ((size_t)(l * BATCH + stream) * 4 + h) * 16384);
#pragma unroll
    for (int t = 0; t < 2; ++t)
#pragma unroll
        for (int r = 0; r < 4; ++r) so[(16 * w + 4 * g + r) * 128 + 32 * s4 + 16 * t + lc] = S[t][r];
}
DEV void ret_scan_job(const Ctx& X, int l, int job) {
    const int sh = job >> 2, q = job & 3, e0 = q * 4096 + X.tid * 8; unsigned short* U = (unsigned short*)(X.ws + WS_U);
    if (sh < BATCH * 4) { const int b = sh >> 2, h = sh & 3; const float gC = __expf(ret_log_g(h) * 64.f); float r8[8];
#pragma unroll
        for (int i = 0; i < 8; ++i) r8[i] = 0.f;
        constexpr int RB = (NCH % 8 == 0) ? 8 : 4;
        for (int n0 = 0; n0 < NCH; n0 += RB) { u32x4 uw[RB];
#pragma unroll
            for (int k = 0; k < RB; ++k) uw[k] = *(const u32x4*)(U + (size_t)((b * NCH + n0 + k) * 4 + h) * 16384 + e0);
#pragma unroll
            for (int k = 0; k < RB; ++k) { float u8[8]; unpack8h(uw[k], u8); *(u32x4*)(U + (size_t)((b * NCH + n0 + k) * 4 + h) * 16384 + e0) = pack8h(r8);
#pragma unroll
                for (int i = 0; i < 8; ++i) r8[i] = r8[i] * gC + u8[i]; } }
        float* o = X.out + O_RETP + ((size_t)(l * BATCH + b) * 4 + h) * 16384 + e0; *(f32x4*)o = (f32x4){r8[0], r8[1], r8[2], r8[3]}; *(f32x4*)(o + 4) = (f32x4){r8[4], r8[5], r8[6], r8[7]}; }
    else { const int sb = (sh - BATCH * 4) >> 2, h = sh & 3; const float gC = __expf(ret_log_g(h) * 32.f); const float* s0 = INP(I_SRET) + ((size_t)(l * DB + sb) * 4 + h) * 16384 + e0;
        unsigned short* p = U + (size_t)((NPCH + sb) * 4 + h) * 16384 + e0; const f32x4 a0 = *(const f32x4*)s0, a1 = *(const f32x4*)(s0 + 4); float u8[8]; unpack8h(*(const u32x4*)p, u8);
        const float a8[8] = {a0.x, a0.y, a0.z, a0.w, a1.x, a1.y, a1.z, a1.w}; *(u32x4*)p = pack8h(a8);
        float* o = X.out + O_RETS + ((size_t)(l * DB + sb) * 4 + h) * 16384 + e0;
        *(f32x4*)o = a0 * gC + (f32x4){u8[0], u8[1], u8[2], u8[3]}; *(f32x4*)(o + 4) = a1 * gC + (f32x4){u8[4], u8[5], u8[6], u8[7]}; }
}
DEV void lru_scan_job(const Ctx& X, int l, int job) {
    const unsigned short* LRA = (const unsigned short*)(X.ws + WS_LRA); const unsigned short* LRH = (const unsigned short*)(X.ws + WS_LRH); const int ch = X.tid;
    if (job < BATCH) { const int b = job; float carry = 0.f; float* LRC = (float*)(X.ws + WS_LRC);
        float ca[NCH], chh[NCH];
#pragma unroll
        for (int n = 0; n < NCH; ++n) { const size_t last = (size_t)((b * NCH + n) * 64 + 63) * 512 + ch; ca[n] = h2f(LRA[last]); chh[n] = h2f(LRH[last]); }
#pragma unroll
        for (int n = 0; n < NCH; ++n) { LRC[(size_t)(b * NCH + n) * 512 + ch] = carry; carry = ca[n] * carry + chh[n]; }
        X.out[O_LHP + (size_t)(l * BATCH + b) * 512 + ch] = carry; }
    else { const int sb = job - BATCH; const size_t last = (size_t)(MP + 32 * sb + 31) * 512 + ch; X.out[O_LHS + (size_t)(l * DB + sb) * 512 + ch] = h2f(LRA[last]) * INP(I_SLH)[(size_t)(l * DB + sb) * 512 + ch] + h2f(LRH[last]); }
}
DEV void sg_out_job(const Ctx& X, int l, int job) {
    int row0, C, h; if (job < BATCH * (SEQ / 128) * 4) { h = job & 3; row0 = (job >> 2) * 128; C = 128; } else { const int j2 = job - BATCH * (SEQ / 128) * 4; h = j2 & 3; row0 = MP + 32 * (j2 >> 2); C = 32; }
    const bf16* VN = (const bf16*)(X.ws + WS_VN); const bf16* P = (const bf16*)(X.ws + WS_HP); bf16* MRG = (bf16*)(X.ws + WS_MRG);
    const bf16* Wm = (const bf16*)(X.ws + WS_SGW) + (size_t)(l * 4 + h) * 16384; LAS unsigned char* Vs = X.lds;
    for (int idx = X.tid; idx < C * 16; idx += NTHREADS) { const int j = idx >> 4, o = (idx & 15) * 8; *(LAS u32x4*)(Vs + j * LD136 + o * 2) = *(const u32x4*)(VN + (size_t)(row0 + j) * 512 + h * 128 + o); }
    LDS_SYNC();
    LAS float* Os = (LAS float*)(X.lds + 34816);
    for (int it = X.wave; it < C / 16; it += NWAVES) { f32x4 acc[8];
#pragma unroll
        for (int t = 0; t < 8; ++t) acc[t] = (f32x4){0.f, 0.f, 0.f, 0.f};
        const int nks = (C == 128 && it < 4) ? 2 : C / 32;
        for (int ks = 0; ks < nks; ++ks) { const bf16x8 a = glb_frag(Wm, 4, it, ks, X.lane);
#pragma unroll
            for (int t = 0; t < 8; ++t) acc[t] = mfma16(a, lds_trfrag(Vs, LD136, 32 * ks, 16 * t, X.lane), acc[t]); }
#pragma unroll
        for (int r = 0; r < 4; ++r) { const int i = 16 * it + 4 * (X.lane >> 4) + r; const float bs = INP(I_SGBS)[(size_t)(l * 4 + h) * 128 + i];
#pragma unroll
            for (int t = 0; t < 8; ++t) Os[i * 132 + 16 * t + (X.lane & 15)] = acc[t][r] + bs; } }
    LDS_SYNC();
    for (int idx = X.tid; idx < C * 8; idx += NTHREADS) { const int i = idx >> 3, e0 = (idx & 7) * 16; float cu[16], o[16];
        const bf16* pc = P + (size_t)(row0 + i) * NPROJ + 3072 + h * 128 + e0; unpack8(*(const u32x4*)pc, cu); unpack8(*(const u32x4*)(pc + 8), cu + 8);
#pragma unroll
        for (int k = 0; k < 16; ++k) o[k] = geluf_(cu[k]) * Os[i * 132 + e0 + k];
        bf16* dst = MRG + (size_t)(row0 + i) * D + 1024 + h * 128 + e0; *(u32x4*)dst = pack8(o); *(u32x4*)(dst + 8) = pack8(o + 8); }
    LDS_SYNC();
}

DEV void ret_out_unit(const Ctx& X, int l, int ck, int h) {
    const Chunk c = chunk_of(ck); const bf16* P = (const bf16*)(X.ws + WS_HP); const float* rot = (const float*)(X.ws + WS_ROT); const float lg = ret_log_g(h);
    LAS unsigned char* Qs = X.lds; LAS unsigned char* Ks = X.lds + 17408; LAS unsigned char* Vs = X.lds + 34816; LAS unsigned char* Ss = X.lds + 52224; LAS unsigned char* Ps = X.lds + 87040; LAS float* Os = (LAS float*)(X.lds + 96256);
    for (int idx = X.tid; idx < c.C * 8; idx += NTHREADS) { const int j = idx >> 3, d = (idx & 7) * 8; const bf16* pr = P + (size_t)(c.row0 + j) * NPROJ + h * 128; const float* rr = rot + (size_t)(c.rot0 + j) * 128;
        rot_piece(pr, rr, d, 1.f, Qs, j); rot_piece(pr + 512, rr, d, 0.08838834764831845f, Ks, j); }
    for (int idx = X.tid; idx < c.C * 16; idx += NTHREADS) { const int j = idx >> 4, o = (idx & 15) * 8; *(LAS u32x4*)(Vs + j * LD136 + o * 2) = *(const u32x4*)(P + (size_t)(c.row0 + j) * NPROJ + 1024 + h * 128 + o); }
    { const unsigned short* U = (const unsigned short*)(X.ws + WS_U) + (size_t)(ck * 4 + h) * 16384;
      for (int idx = X.tid; idx < 128 * 16; idx += NTHREADS) { const int d = idx >> 4, o = (idx & 15) * 8; float u8[8]; unpack8h(*(const u32x4*)(U + d * 128 + o), u8);
          *(LAS u32x4*)(Ss + d * LD136 + o * 2) = pack8(u8); } }
    LDS_SYNC();
    { const int nt = c.C / 16;
      for (int tt = X.wave; tt < nt * nt; tt += NWAVES) { const int it = tt / nt, jt = tt % nt; f32x4 acc = (f32x4){0.f, 0.f, 0.f, 0.f};
          if (jt <= it) {
#pragma unroll
              for (int ks = 0; ks < 4; ++ks) acc = mfma16(lds_rowfrag(Qs, LD136, 16 * it, 32 * ks, X.lane), lds_rowfrag(Ks, LD136, 16 * jt, 32 * ks, X.lane), acc); }
          const int j = 16 * jt + (X.lane & 15);
#pragma unroll
          for (int r = 0; r < 4; ++r) { const int i = 16 * it + 4 * (X.lane >> 4) + r; *(LAS bf16*)(Ps + i * LD72 + j * 2) = (bf16)((j <= i) ? f2bf(acc[r] * __expf(lg * (float)(i - j))) : 0u); } } }
    LDS_SYNC();
    { const int et = X.wave;
      for (int it = 0; it < c.C / 16; ++it) { f32x4 acc = (f32x4){0.f, 0.f, 0.f, 0.f};
#pragma unroll
          for (int ks = 0; ks < 4; ++ks) acc = mfma16(lds_rowfrag(Qs, LD136, 16 * it, 32 * ks, X.lane), lds_trfrag(Ss, LD136, 32 * ks, 16 * et, X.lane), acc);
#pragma unroll
          for (int r = 0; r < 4; ++r) acc[r] *= __expf(lg * (float)(16 * it + 4 * (X.lane >> 4) + r + 1));
          for (int ks = 0; ks < c.C / 32; ++ks) acc = mfma16(lds_rowfrag(Ps, LD72, 16 * it, 32 * ks, X.lane), lds_trfrag(Vs, LD136, 32 * ks, 16 * et, X.lane), acc);
#pragma unroll
          for (int r = 0; r < 4; ++r) Os[(16 * it + 4 * (X.lane >> 4) + r) * 132 + 16 * et + (X.lane & 15)] = acc[r]; } }
    LDS_SYNC();
    { const int t0 = X.tid >> 3, part = X.tid & 7, t = t0 < c.C ? t0 : c.C - 1; float o[16]; float s = 0.f;
#pragma unroll
      for (int i = 0; i < 16; ++i) { o[i] = Os[t * 132 + 16 * part + i]; s += o[i]; }
      s += SHFL_XOR(s, 1); s += SHFL_XOR(s, 2); s += SHFL_XOR(s, 4); const float mean = s * (1.f / 128.f); float s2 = 0.f;
#pragma unroll
      for (int i = 0; i < 16; ++i) { o[i] -= mean; s2 += o[i] * o[i]; }
      s2 += SHFL_XOR(s2, 1); s2 += SHFL_XOR(s2, 2); s2 += SHFL_XOR(s2, 4); const float rstd = rsqf_(s2 * (1.f / 128.f) + LN_EPS);
      if (t0 < c.C) { const int row = c.row0 + t, cc = h * 128 + 16 * part; float ag[16]; const bf16* pg = P + (size_t)row * NPROJ + 1536 + cc; unpack8(*(const u32x4*)pg, ag); unpack8(*(const u32x4*)(pg + 8), ag + 8);
          const float* gn = INP(I_RETG) + l * 512 + cc;
#pragma unroll
          for (int i = 0; i < 16; ++i) o[i] = o[i] * rstd * gn[i] * siluf_(ag[i]);
          bf16* dst = (bf16*)(X.ws + WS_MRG) + (size_t)row * D + cc; *(u32x4*)dst = pack8(o); *(u32x4*)(dst + 8) = pack8(o + 8); } }
    LDS_SYNC();
}
DEV void m3_rows(const Ctx& X, int l, int rgw, int rngw) {
    const bf16* P = (const bf16*)(X.ws + WS_HP); bf16* MRG = (bf16*)(X.ws + WS_MRG); const unsigned short* LRA = (const unsigned short*)(X.ws + WS_LRA); const unsigned short* LRH = (const unsigned short*)(X.ws + WS_LRH);
    const float* LRC = (const float*)(X.ws + WS_LRC); const unsigned short* DNO = (const unsigned short*)(X.ws + WS_DNO); const int c8 = 8 * X.lane;
    for (int row = rgw; row < M; row += rngw) {
        { const float* cr = row < MP ? LRC + (size_t)(row >> 6) * 512 + c8 : INP(I_SLH) + (size_t)(l * DB + ((row - MP) >> 5)) * 512 + c8; float by[8], o[8], la[8], lh[8]; unpack8(*(const u32x4*)(P + (size_t)row * NPROJ + 2048 + c8), by); unpack8h(*(const u32x4*)(LRA + (size_t)row * 512 + c8), la); unpack8h(*(const u32x4*)(LRH + (size_t)row * 512 + c8), lh);
#pragma unroll
          for (int i = 0; i < 8; ++i) o[i] = (la[i] * cr[i] + lh[i]) * geluf_(by[i]);
          *(u32x4*)(MRG + (size_t)row * D + 512 + c8) = pack8(o); }
        { float o[8], z[8]; float ss = 0.f; unpack8(*(const u32x4*)(P + (size_t)row * NPROJ + 5632 + c8), z); unpack8h(*(const u32x4*)(DNO + (size_t)row * 512 + c8), o);
#pragma unroll
          for (int i = 0; i < 8; ++i) ss += o[i] * o[i];
          ss += SHFL_XOR(ss, 1); ss += SHFL_XOR(ss, 2); ss += SHFL_XOR(ss, 4); ss += SHFL_XOR(ss, 8); const float rms = rsqf_(ss * (1.f / 128.f) + LN_EPS);
          const float* gn = INP(I_DNG) + l * 128 + (c8 & 127);
#pragma unroll
          for (int i = 0; i < 8; ++i) o[i] = o[i] * rms * gn[i] * siluf_(z[i]);
          *(u32x4*)(MRG + (size_t)row * D + 1536 + c8) = pack8(o); } }
    { const size_t gt = (size_t)X.wg * NTHREADS + X.tid, GT = (size_t)X.G * NTHREADS;
      for (size_t i = gt; i < (size_t)(BATCH + DB) * 3 * 1536; i += GT) { const int cc = (int)(i % 1536), tt = (int)((i / 1536) % 3), s = (int)(i / 4608);
          if (s < BATCH) X.out[O_DCP + ((size_t)(l * BATCH + s) * 3 + tt) * 1536 + cc] = bf2f(P[(size_t)(s * SEQ + SEQ - 3 + tt) * NPROJ + 4096 + cc]);
          else X.out[O_DCS + ((size_t)(l * DB + (s - BATCH)) * 3 + tt) * 1536 + cc] = bf2f(P[(size_t)(MP + 32 * (s - BATCH) + 29 + tt) * NPROJ + 4096 + cc]); } }
}

#ifndef MK_PER_PHASE
#define MK_PER_PHASE 0
#endif
constexpr int NPHASE = 25;
#define IN(k) (lo <= (k) && (k) < hi)
#define SEAM(k) do { if (!MK_PER_PHASE && IN((k) + 1)) { xcd_barrier(bar); if (PROBE_K == 50) xcd_barrier(bar); } } while (0)
#ifndef PROBE_K
#define PROBE_K (-1)
#endif
#ifdef HOST_EMU
#define PH_BEGIN(k) ((void)0)
#define PH_END(k) ((void)0)
#else
#define PH_BEGIN(k) unsigned long long _pt0 = 0; if (PROBE_K == (k)) _pt0 = __builtin_amdgcn_s_memrealtime()
#define PH_END(k) do { if (PROBE_K == (k)) { const unsigned long long _pt1 = __builtin_amdgcn_s_memrealtime(); while (__builtin_amdgcn_s_memrealtime() - _pt1 < 4ull * (_pt1 - _pt0)) __builtin_amdgcn_s_sleep(8); } } while (0)
#endif
template <int l> DEV void layer_phases(const Ctx& X, const XcdBarrier& bar, const int lo, const int hi) {
    bf16* XB = (bf16*)(X.ws + WS_XB); bf16* HB = (bf16*)(X.ws + WS_HP); bf16* MRG = (bf16*)(X.ws + WS_MRG); const float* STAT = (const float*)(X.ws + WS_STAT);
    float* Zk0 = (float*)(X.ws + (((3 * l + 0) & 1) ? WS_XC : WS_Z)); float* Zk1 = (float*)(X.ws + (((3 * l + 1) & 1) ? WS_XC : WS_Z)); float* Zk2 = (float*)(X.ws + (((3 * l + 2) & 1) ? WS_XC : WS_Z));
    const bool FUSE = X.G == (MP / 256) * (D / 256);
    const float* gprev = l ? INP(I_LN3G) + (l - 1) * D : nullptr; const float* bprev = l ? INP(I_LN3B) + (l - 1) * D : nullptr;
        const int pb = 1 + 12 * l;
        if (IN(pb + 0)) { PH_BEGIN(0); pg8::Gemm g{XB, (const bf16*)(X.ws + WS_W1I), M, 2 * FF, D, D}; pg8::StaticOrder S; S.init(M, 2 * FF, X.G, X.wg); EpiSwiglu E{HB};
            pg8::gemm_phase<EpiSwiglu, pg8::StaticOrder, true, true>(X.lds, g, S, E);
            TAIL_BEGIN((M / 256) * (2 * FF / 256)) if (l == 0) { TAIL_CONV(0, T_WMO, 0, CV_ALL) TAIL_CONV(0, T_W2I, 0, 2400) } TAIL_END
            SEAM(pb + 0); PH_END(0); }
        if (IN(pb + 1)) { PH_BEGIN(1); pg8::Gemm g{HB, (const bf16*)(X.ws + WS_W1O), MP, D, FF, FF}; pg8::StaticOrder S; S.init(MP, D, X.G, X.wg); EpiResid E{l == 0 ? INP(I_XP) : nullptr, Zk1  , STAT, gprev, bprev, Zk0, 0.5f};
            if (FUSE) { EpiResidLn EL{X.ws, X.out, l == 0, (3 * l + 1) & 1, 0, l, 0.5f}; pg8::gemm_phase<EpiResidLn, pg8::StaticOrder, false, true>(X.lds, g, S, EL); }
            else pg8::gemm_phase<EpiResid, pg8::StaticOrder, true, true>(X.lds, g, S, E);
            pg8::Gemm g2{HB, (const bf16*)(X.ws + WS_W1O), M, D, KS_FF, FF}; pg8::SplitOrder S2; S2.init(MP / 256, MS / 256, D / 256, FF / KS_FF, KS_FF, X.G, X.wg); EpiPart E2{(float*)(X.ws + WS_PART), KS_FF};
            pg8::gemm_phase<EpiPart, pg8::SplitOrder, true, true>(X.lds, g2, S2, E2);
            TAIL_BEGIN((MS / 256) * (D / 256) * (FF / KS_FF)) if (l == 0) { TAIL_CONV(0, T_W2I, 2400, 5400) } TAIL_END
            SEAM(pb + 1); PH_END(1); }
        if (IN(pb + 2)) { PH_BEGIN(2); ln_phase(X, Zk0, INP(I_LN1G) + l * D, INP(I_LN1B) + l * D, nullptr, true, l == 0 ? INP(I_XS) : nullptr, Zk1, gprev, bprev, 0.5f, FF / KS_FF, FUSE); SEAM(pb + 2); PH_END(2); }
        if (IN(pb + 3)) { PH_BEGIN(3); pg8::Gemm g{XB, (const bf16*)(X.ws + WS_WMI), M, NPADW, D, D}; pg8::StaticOrder S; S.init(M, NPADW, X.G, X.wg); EpiProj E{HB, (float*)(X.ws + WS_GAB)};
            pg8::gemm_phase<EpiProj, pg8::StaticOrder, true, true>(X.lds, g, S, E);
            TAIL_BEGIN((M / 256) * (NPADW / 256)) if (l == 0) { TAIL_CONV(0, T_W2I, 5400, CV_ALL) TAIL_CONV(0, T_W2O, 0, CV_ALL) } else { TAIL_CONV(l, T_WMO, 0, CV_ALL) TAIL_CONV(l, T_W2I, 0, CV_M1B_LO) } TAIL_END
            SEAM(pb + 3); PH_END(3); }
        if (IN(pb + 4)) { PH_BEGIN(4);
            { PH_BEGIN(20); sg_ln_rows(X, l); PH_END(20); }
            { PH_BEGIN(21); for (int u = (X.wg + X.G - (X.G / 2) % X.G) % X.G; u < NCHUNK * 4; u += X.G) ret_u_unit(X, u >> 2, u & 3); PH_END(21); }
            { PH_BEGIN(22);
              for (int u = X.wg; u < NCHUNK * 4; u += X.G) {
                  constexpr bool last = l + 1 == DEPTH; constexpr int clo = last ? CV_M1B_LO : CV_M1_LO, chi = last ? CV_M1B_HI : CV_M1_HI; const int ci = clo + u * NWAVES + X.wave; const bool cok = ci < chi; float cv[32];
                  dn_prep_unit_a(X, l, u >> 2, u & 3);
                  if (cok) conv_w1i_load(X, last, last ? l : l + 1, ci, cv);
                  __builtin_amdgcn_sched_barrier(0);
                  dn_prep_unit_b(X, l, u >> 2, u & 3);
                  if (cok) conv_w1i_put(X, last, ci, cv);
                  if (clo + u * NWAVES < chi) LDS_SYNC(); }
              PH_END(22); }
            { PH_BEGIN(23); for (int u = (X.wg + X.G - (X.G / 4) % X.G) % X.G; u < NCHUNK * 4; u += X.G) lru_prep_unit(X, l, u >> 2, u & 3); PH_END(23); }
            SEAM(pb + 4); PH_END(4); }
        if (IN(pb + 5)) { PH_BEGIN(5);
            constexpr int NDNP = BATCH * 16, NDNS = DB * 16, NRET = (BATCH + DB) * 16, NLRU = BATCH + DB, NSGJ = BATCH * (SEQ / 128) * 4 + DB * 4, NJOB = NDNP + NDNS + NRET + NLRU + NSGJ;
            const bool dedicated = X.G > NDNP; int j0, js;
            if (dedicated && X.wg < NDNP) { j0 = X.wg; js = NJOB; } else if (dedicated) { j0 = NDNP + (X.wg - NDNP); js = X.G - NDNP; } else { j0 = X.wg; js = X.G; }
            unsigned long long _pt0b = 0; if (PROBE_K == 31 || PROBE_K == 30) _pt0b = __builtin_amdgcn_s_memrealtime();
            if (dedicated) { if (X.wg < NDNP) dn_seq_unit(X, l, false, X.wg >> 4, (X.wg >> 2) & 3, X.wg & 3); }
            else for (int r = X.wg; r < NDNP; r += X.G) dn_seq_unit(X, l, false, r >> 4, (r >> 2) & 3, r & 3);
            if (!dedicated) j0 = NDNP + X.wg;
            for (int j = (dedicated && X.wg < NDNP) ? NJOB : j0; j < NJOB; j += js) { int r = j - NDNP;
                if (r < NDNS) { dn_seq_unit(X, l, true, r >> 4, (r >> 2) & 3, r & 3); continue; } r -= NDNS;
                if (r < NRET) { ret_scan_job(X, l, r); continue; } r -= NRET;
                if (r < NLRU) { lru_scan_job(X, l, r); continue; } r -= NLRU;
                sg_out_job(X, l, r); }
            if (dedicated && X.wg < NDNP && PROBE_K == 30) { const unsigned long long _pt1 = __builtin_amdgcn_s_memrealtime(); while (__builtin_amdgcn_s_memrealtime() - _pt1 < 4ull * (_pt1 - _pt0b)) __builtin_amdgcn_s_sleep(8); }
            if (!dedicated || X.wg >= NDNP) { const int cgw = dedicated ? (X.wg - NDNP) * NWAVES + X.wave : X.gw, cng = dedicated ? (X.G - NDNP) * NWAVES : X.NGW;
                __syncthreads();
                if (l + 1 < DEPTH) { conv_task(X, l + 1, T_W1I, CV_M1_HI, CV_ALL, cgw, cng); conv_task(X, l + 1, T_W1O, 0, CV_ALL, cgw, cng); }
                else { conv_task(X, l, T_W2I, CV_M1B_HI, CV_ALL, cgw, cng); conv_task(X, l, T_W2O, 0, CV_ALL, cgw, cng); }
                if (PROBE_K == 31) { const unsigned long long _pt1 = __builtin_amdgcn_s_memrealtime(); while (__builtin_amdgcn_s_memrealtime() - _pt1 < 4ull * (_pt1 - _pt0b)) __builtin_amdgcn_s_sleep(8); } }
            SEAM(pb + 5); PH_END(5); }
        if (IN(pb + 6)) { PH_BEGIN(6); for (int u = (X.wg + X.G - (3 * X.G / 4) % X.G) % X.G; u < NCHUNK * 4; u += X.G) ret_out_unit(X, l, u >> 2, u & 3);
            if (X.G == 256 && NCHUNK * 4 == 576) { if (X.wg < 192) m3_rows(X, l, X.wg * NWAVES + X.wave, 192 * NWAVES); else m3_rows(X, l, M, 1); }
            else m3_rows(X, l, X.gw, X.NGW);
            SEAM(pb + 6); PH_END(6); }
        if (IN(pb + 7)) { PH_BEGIN(7); pg8::Gemm g{MRG, (const bf16*)(X.ws + WS_WMO), MP, D, D, D}; pg8::StaticOrder S; S.init(MP, D, X.G, X.wg); EpiResid E{nullptr, Zk0, STAT, INP(I_LN1G) + l * D, INP(I_LN1B) + l * D, Zk1, 1.0f};
            if (FUSE) { EpiResidLn EL{X.ws, X.out, 0, (3 * l) & 1, 1, l, 1.0f}; pg8::gemm_phase<EpiResidLn, pg8::StaticOrder, false, true>(X.lds, g, S, EL); }
            else pg8::gemm_phase<EpiResid, pg8::StaticOrder, true, true>(X.lds, g, S, E);
            pg8::Gemm g2{MRG, (const bf16*)(X.ws + WS_WMO), M, D, KS_D, D}; pg8::SplitOrder S2; S2.init(MP / 256, MS / 256, D / 256, D / KS_D, KS_D, X.G, X.wg); EpiPart E2{(float*)(X.ws + WS_PART), KS_D};
            pg8::gemm_phase<EpiPart, pg8::SplitOrder, true, true>(X.lds, g2, S2, E2);
            TAIL_BEGIN((MS / 256) * (D / 256) * (D / KS_D)) if (l + 1 < DEPTH) { TAIL_CONV(l + 1, T_WMI, 0, 3700) } TAIL_END
            SEAM(pb + 7); PH_END(7); }
        if (IN(pb + 8)) { PH_BEGIN(8); ln_phase(X, Zk1, INP(I_LN2G) + l * D, INP(I_LN2B) + l * D, nullptr, true, nullptr, Zk0, INP(I_LN1G) + l * D, INP(I_LN1B) + l * D, 1.0f, D / KS_D, FUSE); SEAM(pb + 8); PH_END(8); }
        if (IN(pb + 9)) { PH_BEGIN(9); pg8::Gemm g{XB, (const bf16*)(X.ws + WS_W2I), M, 2 * FF, D, D}; pg8::StaticOrder S; S.init(M, 2 * FF, X.G, X.wg); EpiSwiglu E{HB};
            pg8::gemm_phase<EpiSwiglu, pg8::StaticOrder, true, true>(X.lds, g, S, E);
            TAIL_BEGIN((M / 256) * (2 * FF / 256)) if (l + 1 < DEPTH) { TAIL_CONV(l + 1, T_WMI, 3700, CV_ALL) } TAIL_END
            SEAM(pb + 9); PH_END(9); }
        if (IN(pb + 10)) { PH_BEGIN(10); pg8::Gemm g{HB, (const bf16*)(X.ws + WS_W2O), MP, D, FF, FF}; pg8::StaticOrder S; S.init(MP, D, X.G, X.wg); EpiResid E{nullptr, Zk1, STAT, INP(I_LN2G) + l * D, INP(I_LN2B) + l * D, Zk2, 0.5f};
            if (FUSE) { EpiResidLn EL{X.ws, X.out, 0, (3 * l + 1) & 1, 2, l, 0.5f}; pg8::gemm_phase<EpiResidLn, pg8::StaticOrder, false, true>(X.lds, g, S, EL); }
            else pg8::gemm_phase<EpiResid, pg8::StaticOrder, true, true>(X.lds, g, S, E);
            pg8::Gemm g2{HB, (const bf16*)(X.ws + WS_W2O), M, D, KS_FF, FF}; pg8::SplitOrder S2; S2.init(MP / 256, MS / 256, D / 256, FF / KS_FF, KS_FF, X.G, X.wg); EpiPart E2{(float*)(X.ws + WS_PART), KS_FF};
            pg8::gemm_phase<EpiPart, pg8::SplitOrder, true, true>(X.lds, g2, S2, E2);
            TAIL_BEGIN((MS / 256) * (D / 256) * (FF / KS_FF)) if (l + 1 < DEPTH) { TAIL_CONV(l + 1, T_W1I, 0, CV_M1_LO) } TAIL_END
            SEAM(pb + 10); PH_END(10); }
        if (IN(pb + 11)) { PH_BEGIN(11); ln_phase(X, Zk2, INP(I_LN3G) + l * D, INP(I_LN3B) + l * D, l == DEPTH - 1 ? X.out : nullptr, l != DEPTH - 1, nullptr, Zk1, INP(I_LN2G) + l * D, INP(I_LN2B) + l * D, 0.5f, FF / KS_FF, FUSE); SEAM(pb + 11); PH_END(11); }
}
struct Args { const float* in[N_IN]; float* out; unsigned char* ws; int ph_lo, ph_hi; };
__global__ void __launch_bounds__(NTHREADS, 2) fwd(Args args) {
    LDS_DECL(lds);
    Ctx X; X.lds = (LAS unsigned char*)lds; X.tid = threadIdx.x; X.lane = X.tid & 63; X.wave = __builtin_amdgcn_readfirstlane(X.tid >> 6); X.wg = blockIdx.x; X.G = gridDim.x;
    X.gw = X.wg * NWAVES + X.wave; X.NGW = X.G * NWAVES; X.out = args.out; X.ws = args.ws;
    volatile LAS unsigned* MISC = (volatile LAS unsigned*)(X.lds + MISC_OFF);
    if (X.tid < 32) MISC[X.tid] = 0u;
    __syncthreads();
    XcdBarrier bar; bar.bar = (unsigned*)(X.ws + WS_CTL) + CW_BAR; bar.x = 0; bar.st = nullptr;
    if (!MK_PER_PHASE) bar = xcd_barrier_post((unsigned*)(X.ws + WS_CTL) + CW_BAR, MISC + 8);
    const int lo = args.ph_lo, hi = args.ph_hi;
    if (IN(0)) { PH_BEGIN(13); convert_weights(X, 0, 1 | 2, X.gw, X.NGW); prologue_misc(X); SEAM(0); PH_END(13); }
    layer_phases<0>(X, bar, lo, hi);
    layer_phases<1>(X, bar, lo, hi);
}

extern "C" void kernel_launch(void* const* d_in, const int* in_sizes, int n_in, void* d_out, int out_size, void* d_ws, size_t ws_size, hipStream_t stream) {
    static int grid = 0;
    if (grid == 0) {
        if (n_in != N_IN || (size_t)out_size != O_END || ws_size < WS_END) { fprintf(stderr, "kernel_launch: shape mismatch: n_in %d (want %d), out %d (want %zu), ws %zu (want >= %zu); nothing launched\n", n_in, (int)N_IN, out_size, (size_t)O_END, ws_size, (size_t)WS_END); grid = -1; return; }
        int dev = 0, cus = 0, per_cu = 0;
        if (hipGetDevice(&dev) != hipSuccess || hipDeviceGetAttribute(&cus, hipDeviceAttributeMultiprocessorCount, dev) != hipSuccess) { grid = -1; return; }
        if (hipFuncSetAttribute((const void*)fwd, hipFuncAttributeMaxDynamicSharedMemorySize, LDS_BYTES) != hipSuccess) { fprintf(stderr, "kernel_launch: hipFuncSetAttribute failed\n"); grid = -1; return; }
        if (hipOccupancyMaxActiveBlocksPerMultiprocessor(&per_cu, (const void*)fwd, NTHREADS, LDS_BYTES) != hipSuccess || per_cu < 1) fprintf(stderr, "kernel_launch: occupancy query reports %d\n", per_cu);
        (void)hipGetLastError();
        grid = cus;
    }
    if (grid < 0) return;
    if (hipMemsetAsync((char*)d_ws + WS_CTL, 0, CTL_ZERO_BYTES, stream) != hipSuccess) return;
    Args a{};
    for (int i = 0; i < N_IN; ++i) a.in[i] = (const float*)d_in[i];
    a.out = (float*)d_out; a.ws = (unsigned char*)d_ws;
#ifdef HOST_EMU
    g_emu_in = (const float* const*)d_in;
#endif
#if MK_PER_PHASE
    for (int p = 0; p < NPHASE; ++p) { a.ph_lo = p; a.ph_hi = p + 1;
#ifdef HOST_EMU
        if (getenv("EMU_PH_HI") && p >= atoi(getenv("EMU_PH_HI"))) break;
        fprintf(stderr, "[emu] phase %d\n", p);
#endif
        hipLaunchKernelGGL(fwd, dim3(grid), dim3(NTHREADS), LDS_BYTES, stream, a); }
#else
    a.ph_lo = 0; a.ph_hi = NPHASE;
    hipLaunchKernelGGL(fwd, dim3(grid), dim3(NTHREADS), LDS_BYTES, stream, a);
#endif
}
#ifdef HOST_EMU
extern "C" void emu_config(int* in_sizes, int* n_in, int* out_sizes, int* n_out, size_t* ws_bytes) {
    const int G = GW; int s[N_IN] = { MP * D, MS * D, DEPTH * DB * 4 * 16384, DEPTH * DB * G, DEPTH * DB * 3 * G, DEPTH * DB * 4 * 16384, DEPTH * DB * 3 * 1536,
        DEPTH * D * 2 * FF, DEPTH * FF * D, DEPTH * D, DEPTH * D, DEPTH * D * DIN, DEPTH * G, DEPTH * 4 * G, DEPTH * G, DEPTH * 8 * 4096, DEPTH * G, DEPTH * 8 * 4096, DEPTH * G, DEPTH * G,
        DEPTH * G, DEPTH * G, DEPTH * 4 * 16384, DEPTH * 4 * 128, DEPTH * 4 * 1536, DEPTH * 4, DEPTH * 4, DEPTH * 128, DEPTH * D * D, DEPTH * D, DEPTH * D, DEPTH * D * 2 * FF, DEPTH * FF * D, DEPTH * D, DEPTH * D };
    for (int i = 0; i < N_IN; ++i) in_sizes[i] = s[i]; *n_in = N_IN;
    const size_t o[14] = { O_YP, O_YS, O_RETP, O_LHP, O_LCP, O_DNP, O_DCP, O_RETS, O_LHS, O_LCS, O_DNS, O_DCS, O_SGV, O_END };
    for (int i = 0; i < 13; ++i) out_sizes[i] = (int)(o[i + 1] - o[i]); *n_out = 13; *ws_bytes = WS_END;
}
extern "C" int emu_regions(const char** names, size_t* offs, size_t* bytes, int maxn) {
    int n = 0;
#define REG(nm, off, by) do { names[n] = nm; offs[n] = off; bytes[n] = by; ++n; } while (0)
    REG("xb", WS_XB, (size_t)M * D * 2); REG("xc", WS_XC, (size_t)M * D * 4); REG("z", WS_Z, (size_t)M * D * 4); REG("hp", WS_HP, (size_t)M * NPROJ * 2); REG("gab", WS_GAB, (size_t)M * 8 * 4);
    REG("mrg", WS_MRG, (size_t)M * D * 2); REG("w1i", WS_W1I, (size_t)2 * FF * D * 2); REG("wmi", WS_WMI, (size_t)NPADW * D * 2); REG("dno", WS_DNO, (size_t)M * 512 * 4); REG("vn", WS_VN, (size_t)M * 512 * 2);
    REG("xslot", WS_XSLOT, (size_t)MP * 8 * 8); REG("ctl", WS_CTL, (size_t)1 << 20); REG("stat", WS_STAT, (size_t)M * 2 * 4); REG("dnu", WS_DNU, (size_t)M * 512 * 2); REG("dnw", WS_DNW, (size_t)M * 512 * 2); REG("lrh", WS_LRH, (size_t)M * 512 * 4);
#undef REG
    return n;
}
#endif
```
